# Optimizing an MI355X kernel written in HIP

```python
import math
import jax, jax.numpy as jnp
from jax import lax
import numpy as np

D_MODEL = 1024
BATCH = 2
SEQ = 8192
DEPTH = 1

PLE_DIM = 256
SGU_CHUNK = 128
SGU_GROUPS = 8
SGU_WIDTH = D_MODEL
SGU_GROUP_DIM = SGU_WIDTH // SGU_GROUPS
ATT_HEADS = 16
HEAD_DIM = 64
ATT_WIDTH = ATT_HEADS * HEAD_DIM
MOBA_BLOCK = 256
MOBA_TOPK = 3
Q_CHUNK = 64
REL_BUCKETS = 32
REL_MAX_DIST = 1024
D_FF = 4 * D_MODEL
EPS = 1e-6
SPLITS = (SGU_WIDTH, SGU_WIDTH, ATT_WIDTH, ATT_WIDTH, ATT_WIDTH, D_MODEL, D_MODEL)
IN_COLS = sum(SPLITS)

kernel_name = "hybrid_gmlp_moba_gated_block"


def rms_norm(x, g):
    xf = x.astype(jnp.float32)
    y = xf * lax.rsqrt(jnp.mean(xf * xf, axis=-1, keepdims=True) + EPS)
    return (y * g.astype(jnp.float32)).astype(x.dtype)


def layer_norm(x, g, b):
    xf = x.astype(jnp.float32)
    mu = jnp.mean(xf, axis=-1, keepdims=True)
    xc = xf - mu
    y = xc * lax.rsqrt(jnp.mean(xc * xc, axis=-1, keepdims=True) + EPS)
    return (y * g.astype(jnp.float32) + b.astype(jnp.float32)).astype(x.dtype)


def rel_bucket(dist):
    n = jnp.maximum(dist, 0)
    max_exact = REL_BUCKETS // 2
    nf = jnp.maximum(n, max_exact).astype(jnp.float32)
    large = max_exact + (jnp.log(nf / max_exact) / math.log(REL_MAX_DIST / max_exact)
                         * (REL_BUCKETS - max_exact)).astype(jnp.int32)
    large = jnp.minimum(large, REL_BUCKETS - 1)
    return jnp.where(n < max_exact, n, large)


def sgu_mixer(u, v, w_s, b_s, ln_g, ln_b):
    B, S, _ = u.shape
    nc = S // SGU_CHUNK
    v = layer_norm(v, ln_g, ln_b)
    vg = v.reshape(B, nc, SGU_CHUNK, SGU_GROUPS, SGU_GROUP_DIM)
    causal = jnp.tril(jnp.ones((SGU_CHUNK, SGU_CHUNK), dtype=bool))
    w = jnp.where(causal, w_s, 0).astype(v.dtype)
    mixed = jnp.einsum('gts,bnsgc->bntgc', w, vg) + b_s.T[None, None, :, :, None].astype(v.dtype)
    return u * mixed.reshape(B, S, SGU_WIDTH)


_gather_blocks = jax.vmap(jax.vmap(lambda blocks, idx: blocks[idx]))


def moba_attention(q, k, v, rel_bias):
    B, H, S, dh = q.shape
    nb = S // MOBA_BLOCK
    topk = min(MOBA_TOPK, nb)
    kb = k.reshape(B, H, nb, MOBA_BLOCK, dh)
    vb = v.reshape(B, H, nb, MOBA_BLOCK, dh)
    k_mean = jnp.mean(kb.astype(jnp.float32), axis=3).astype(k.dtype)
    scale = dh ** -0.5
    table = rel_bias.T
    h_idx = jnp.arange(H)[None, :, None, None, None]
    pos_in_block = jnp.arange(MOBA_BLOCK)
    n_chunks = S // Q_CHUNK
    q_chunks = q.reshape(B, H, n_chunks, Q_CHUNK, dh).transpose(2, 0, 1, 3, 4)
    n_sel = topk * MOBA_BLOCK

    def one_chunk(args):
        c, q_c = args
        q_pos = c * Q_CHUNK + jnp.arange(Q_CHUNK)
        own = (c * Q_CHUNK) // MOBA_BLOCK
        gate = jnp.einsum('bhqd,bhnd->bhqn', q_c, k_mean).astype(jnp.float32)
        gate = jnp.where(jnp.arange(nb) < own, gate, -jnp.inf)
        _, sel = lax.top_k(gate, topk)
        sel_valid = sel < own
        k_sel = _gather_blocks(kb, sel)
        v_sel = _gather_blocks(vb, sel)
        s_sel = jnp.einsum('bhqd,bhqkmd->bhqkm', q_c, k_sel).astype(jnp.float32) * scale
        k_pos_sel = sel[..., None] * MOBA_BLOCK + pos_in_block
        dist_sel = q_pos[:, None, None] - k_pos_sel
        s_sel = s_sel + table[h_idx, rel_bucket(dist_sel)].astype(jnp.float32)
        s_sel = jnp.where(sel_valid[..., None], s_sel, -jnp.inf)
        k_own = lax.dynamic_index_in_dim(kb, own, axis=2, keepdims=False)
        v_own = lax.dynamic_index_in_dim(vb, own, axis=2, keepdims=False)
        s_own = jnp.einsum('bhqd,bhmd->bhqm', q_c, k_own).astype(jnp.float32) * scale
        dist_own = q_pos[:, None] - (own * MOBA_BLOCK + pos_in_block)[None, :]
        s_own = s_own + table[:, rel_bucket(dist_own)].astype(jnp.float32)
        s_own = jnp.where(dist_own >= 0, s_own, -jnp.inf)
        s_all = jnp.concatenate([s_sel.reshape(B, H, Q_CHUNK, n_sel), s_own], axis=-1)
        probs = jax.nn.softmax(s_all, axis=-1).astype(v.dtype)
        p_sel = probs[..., :n_sel].reshape(B, H, Q_CHUNK, topk, MOBA_BLOCK)
        p_own = probs[..., n_sel:]
        return (jnp.einsum('bhqkm,bhqkmd->bhqd', p_sel, v_sel)
                + jnp.einsum('bhqm,bhmd->bhqd', p_own, v_own))

    out = lax.map(one_chunk, (jnp.arange(n_chunks), q_chunks))
    return out.transpose(1, 2, 0, 3, 4).reshape(B, H, S, dh)


def setup_inputs(seed: int = 0) -> dict:
    key = jax.random.key(seed)
    ks = jax.random.split(key, 20)
    f32 = jnp.float32
    nrm = lambda k, shape, s: jax.random.normal(k, shape, f32) * s
    L = DEPTH
    return {
        "x": nrm(ks[0], (BATCH, SEQ, D_MODEL), 1.0),
        "p": nrm(ks[1], (DEPTH, BATCH, SEQ, PLE_DIM), 1.0),
        "norm_mix_g": 1.0 + nrm(ks[2], (L, D_MODEL), 0.05),
        "w_in": nrm(ks[3], (L, D_MODEL, IN_COLS), D_MODEL ** -0.5),
        "w_sgu_spatial": nrm(ks[4], (L, SGU_GROUPS, SGU_CHUNK, SGU_CHUNK), SGU_CHUNK ** -0.5),
        "b_sgu_spatial": 1.0 + nrm(ks[5], (L, SGU_GROUPS, SGU_CHUNK), 0.1),
        "ln_v_g": 1.0 + nrm(ks[6], (L, SGU_WIDTH), 0.05),
        "ln_v_b": nrm(ks[7], (L, SGU_WIDTH), 0.02),
        "rel_bias": nrm(ks[8], (REL_BUCKETS, ATT_HEADS), 0.5),
        "w_out": nrm(ks[9], (L, D_MODEL, D_MODEL), D_MODEL ** -0.5),
        "norm_ffn_g": 1.0 + nrm(ks[10], (L, D_MODEL), 0.05),
        "w_ff1": nrm(ks[11], (L, D_MODEL, D_FF), D_MODEL ** -0.5),
        "w_ff2": nrm(ks[12], (L, D_FF, D_MODEL), D_FF ** -0.5),
        "norm_ple_g": 1.0 + nrm(ks[13], (L, D_MODEL), 0.05),
        "w_ple_gate": nrm(ks[14], (L, D_MODEL, D_MODEL), D_MODEL ** -0.5),
        "w_ple_proj": nrm(ks[15], (L, PLE_DIM, D_MODEL), PLE_DIM ** -0.5),
        "norm_final_g": 1.0 + nrm(ks[16], (D_MODEL,), 0.05),
    }


def reference(x, p, norm_mix_g, w_in, w_sgu_spatial, b_sgu_spatial, ln_v_g, ln_v_b, rel_bias,
              w_out, norm_ffn_g, w_ff1, w_ff2, norm_ple_g, w_ple_gate, w_ple_proj, norm_final_g):
    B, S, _ = x.shape
    offsets = np.cumsum(SPLITS)[:-1].tolist()
    for i in range(DEPTH):
        h = rms_norm(x, norm_mix_g[i])
        proj = h @ w_in[i]
        za_u, za_v, q, k, v_att, g_a, g_b = jnp.split(proj, offsets, axis=-1)
        y_a = sgu_mixer(jax.nn.gelu(za_u), jax.nn.gelu(za_v), w_sgu_spatial[i], b_sgu_spatial[i],
                        ln_v_g[i], ln_v_b[i])
        heads = lambda t: t.reshape(B, S, ATT_HEADS, HEAD_DIM).transpose(0, 2, 1, 3)
        y_b = moba_attention(heads(q), heads(k), heads(v_att), rel_bias)
        y_b = y_b.transpose(0, 2, 1, 3).reshape(B, S, ATT_WIDTH)
        merged = jax.nn.sigmoid(g_a) * y_a + jax.nn.sigmoid(g_b) * y_b
        x = x + merged @ w_out[i]
        h = rms_norm(x, norm_ffn_g[i])
        x = x + jnp.square(jax.nn.relu(h @ w_ff1[i])) @ w_ff2[i]
        gate = jax.nn.sigmoid(rms_norm(x, norm_ple_g[i]) @ w_ple_gate[i])
        x = x + gate * (p[i] @ w_ple_proj[i])
    return rms_norm(x, norm_final_g)
```

```cpp
#include <hip/hip_runtime.h>
#include <cstdio>
#include <cstdint>
#include <cmath>
namespace pg8 {
#define PG8_LAS __attribute__((address_space(3)))
typedef unsigned short bf16_t;
typedef short bf16x8 __attribute__((ext_vector_type(8)));
typedef float f32x4 __attribute__((ext_vector_type(4)));
typedef unsigned u32x4 __attribute__((ext_vector_type(4)));
constexpr int BM = 256, BK = 64, HALF = 128, HTB = HALF * BK * 2  , STAGE_BYTES = 8 * HTB, NXCD = 8, WGM = 8;

__host__ __device__ __forceinline__ int lds_byte(int r, int c) { const int st = (r >> 4) * 2 + (c >> 5), rr = r & 15, cc = c & 31, ob = rr * 64 + cc * 2; return st * 1024 + (ob ^ (((ob >> 9) & 1) << 5)); }
__host__ __device__ __forceinline__ void stage_rc(int b, int& R, int& C) { const int st = b / 1024, sb = b % 1024, swz = sb ^ (((sb >> 9) & 1) << 5); R = (st >> 1) * 16 + swz / 64; C = (st & 1) * 32 + (swz % 64) / 2; }
__host__ __device__ __forceinline__ int perm32(int rho) { const int n = rho >> 4, i = rho & 15; return 8 * (i >> 2) + 4 * n + (i & 3); }

struct Unit { int pm, pn; };
struct Gemm { const bf16_t* A; const bf16_t* Bt; int M, N, K; };

struct StaticOrder {
    int nM, nN, nwg, G, c;
    __host__ __device__ void init(int M, int N, int G_, int c_) { nM = M / BM; nN = N / BM; nwg = nM * nN; G = G_; c = c_; }
    __host__ __device__ bool next(int i, Unit& u) const {
        const long L = (long)i * G + c; if (L >= nwg) return false;
        int wgid = (int)L; { const int q = nwg / NXCD, r = nwg % NXCD, xcd = wgid % NXCD, off = wgid / NXCD; wgid = (xcd < r ? xcd * (q + 1) : r * (q + 1) + (xcd - r) * q) + off; }
        const int nig = WGM * nN, gid = wgid / nig, fm = gid * WGM, gsz = (nM - fm) < WGM ? (nM - fm) : WGM;
        u.pm = fm + ((wgid % nig) % gsz); u.pn = (wgid % nig) / gsz; return true;
    }
    __device__ __forceinline__ void a_ready(const Unit&) const {}
    __device__ __forceinline__ void done(const Unit&) const {}
};

__device__ __forceinline__ unsigned cvt_pk_bf16(float lo, float hi) { unsigned r; asm volatile("v_cvt_pk_bf16_f32 %0, %1, %2" : "=v"(r) : "v"(lo), "v"(hi)); return r; }
typedef float f32x2 __attribute__((ext_vector_type(2)));
__device__ __forceinline__ f32x2 gelu_pk(f32x2 v) {
    const f32x2 av = __builtin_elementwise_abs(v), d = av * 0.2316418882f + 1.0f;
    f32x2 t; t.x = __builtin_amdgcn_rcpf(d.x); t.y = __builtin_amdgcn_rcpf(d.y);
    f32x2 q = t * 0.5307027145f + (-0.7265760135f); q = q * t + 0.7107068705f; q = q * t + (-0.142248368f); q = q * t + 0.127414796f; q = q * t;
    const f32x2 s = (v * v) * (-0.72134752044f);
    f32x2 e; e.x = __builtin_amdgcn_exp2f(s.x); e.y = __builtin_amdgcn_exp2f(s.y);
    const f32x2 m = v * (q * e), r = v - m;
    f32x2 o; o.x = v.x < 0.f ? m.x : r.x; o.y = v.y < 0.f ? m.y : r.y; return o;
}

template <int ACT  > struct EpiBf16 {
    static constexpr bool PERM = true, AFTER_DRAIN = false; static_assert(ACT == 0 || ACT == 1, "EpiBf16: ACT is 0 (none) or 1 (gelu_pk)");
    bf16_t* O; int ldc; const float* bias; int split_cols; size_t split_stride; float scale0;
    __device__ __forceinline__ void operator()(const f32x4 (&acc)[2][2][4][2], const Unit& u, int wr, int wc, int fr, int fq) const {
        const int row0 = u.pm * BM + wr * 64 + fr; int colt = u.pn * BM; bf16_t* base = O;
        float sc = 1.f; if (split_cols) { const int t = colt / split_cols; base += (size_t)t * split_stride; colt -= t * split_cols; if (t == 0) sc = scale0; }
        const int col0 = colt + wc * 32 + 8 * fq, bcol0 = u.pn * BM + wc * 32 + 8 * fq;
        f32x4 bv[2][2];
#pragma unroll
        for (int bj = 0; bj < 2; ++bj)
#pragma unroll
            for (int n = 0; n < 2; ++n) bv[bj][n] = bias ? *(const f32x4*)(bias + bcol0 + bj * HALF + 4 * n) : (f32x4){0.f, 0.f, 0.f, 0.f};
#pragma unroll
        for (int ai = 0; ai < 2; ++ai)
#pragma unroll
            for (int m = 0; m < 4; ++m) { bf16_t* rowp = base + (size_t)(row0 + ai * HALF + m * 16) * ldc + col0;
#pragma unroll
                for (int bj = 0; bj < 2; ++bj) { f32x4 v0 = acc[ai][bj][m][0] + bv[bj][0], v1 = acc[ai][bj][m][1] + bv[bj][1];
                    if (ACT == 1) { f32x2 a = gelu_pk((f32x2){v0[0], v0[1]}), b = gelu_pk((f32x2){v0[2], v0[3]}), c = gelu_pk((f32x2){v1[0], v1[1]}), d = gelu_pk((f32x2){v1[2], v1[3]});
                        v0 = (f32x4){a.x, a.y, b.x, b.y}; v1 = (f32x4){c.x, c.y, d.x, d.y}; }
                    v0 = v0 * sc; v1 = v1 * sc; u32x4 w; w.x = cvt_pk_bf16(v0[0], v0[1]); w.y = cvt_pk_bf16(v0[2], v0[3]); w.z = cvt_pk_bf16(v1[0], v1[1]); w.w = cvt_pk_bf16(v1[2], v1[3]);
                    *(u32x4*)(rowp + bj * HALF) = w; } }
    }
};

__device__ __forceinline__ float sigm(float x) { return __builtin_amdgcn_rcpf(1.0f + __builtin_amdgcn_exp2f(-1.4426950408889634f * x)); }
__device__ __forceinline__ float gelu_t(float x) { return x * sigm(x * (1.5957691216057308f + 0.07135481627260025f * x * x)); }
__device__ __forceinline__ u32x4 pack8(const float (&o)[8]) { u32x4 w; w.x = cvt_pk_bf16(o[0], o[1]); w.y = cvt_pk_bf16(o[2], o[3]); w.z = cvt_pk_bf16(o[4], o[5]); w.w = cvt_pk_bf16(o[6], o[7]); return w; }
constexpr float QSCALE = 0.125f * 1.4426950408889634f;

struct EpiIn {
    static constexpr bool PERM = true, AFTER_DRAIN = false;
    bf16_t *UG, *VS, *Q, *K, *VA, *GB; float* stats1; float* kmean; unsigned* khmax;
    __device__ __forceinline__ void operator()(const f32x4 (&acc)[2][2][4][2], const Unit& u, int wr, int wc, int fr, int fq) const {
        const int row0 = u.pm * BM + wr * 64 + fr, cw = wc * 32 + 8 * fq;
        if (u.pn < 8) {
            bf16_t* base = UG + (size_t)row0 * 1024 + u.pn * 128 + cw;
#pragma unroll
            for (int ai = 0; ai < 2; ++ai)
#pragma unroll
                for (int m = 0; m < 4; ++m) { float o[8];
#pragma unroll
                    for (int n = 0; n < 2; ++n)
#pragma unroll
                        for (int j = 0; j < 4; ++j) o[4 * n + j] = gelu_t(acc[ai][0][m][n][j]) * sigm(acc[ai][1][m][n][j]);
                    *(u32x4*)(base + (size_t)(ai * HALF + m * 16) * 1024) = pack8(o); }
            return;
        }
        const int kind = (u.pn - 8) >> 2, ct = (u.pn - 8) & 3;
        bf16_t* base = (kind == 0 ? VS : kind == 1 ? Q : kind == 2 ? K : kind == 3 ? VA : GB) + (size_t)row0 * 1024 + ct * 256 + cw;
        if (kind == 0) {
#pragma unroll
            for (int ai = 0; ai < 2; ++ai)
#pragma unroll
                for (int m = 0; m < 4; ++m) { float s1 = 0.f, s2 = 0.f;
#pragma unroll
                    for (int bj = 0; bj < 2; ++bj) { float o[8];
#pragma unroll
                        for (int n = 0; n < 2; ++n)
#pragma unroll
                            for (int j = 0; j < 4; ++j) { const float g = gelu_t(acc[ai][bj][m][n][j]); o[4 * n + j] = g; s1 += g; s2 += g * g; }
                        *(u32x4*)(base + (size_t)(ai * HALF + m * 16) * 1024 + bj * HALF) = pack8(o); }
                    s1 += __shfl_xor(s1, 16); s1 += __shfl_xor(s1, 32); s2 += __shfl_xor(s2, 16); s2 += __shfl_xor(s2, 32);
                    if (fq == 0) { float* sp = stats1 + 2 * (size_t)(row0 + ai * HALF + m * 16); atomicAdd(sp, s1); atomicAdd(sp + 1, s2); } }
        } else if (kind == 2) {
            float mx[2] = {0.f, 0.f};
#pragma unroll
            for (int ai = 0; ai < 2; ++ai)
#pragma unroll
                for (int m = 0; m < 4; ++m)
#pragma unroll
                    for (int bj = 0; bj < 2; ++bj) { float o[8]; float ss = 0.f;
#pragma unroll
                        for (int n = 0; n < 2; ++n)
#pragma unroll
                            for (int j = 0; j < 4; ++j) { const float v = acc[ai][bj][m][n][j]; o[4 * n + j] = v; ss += v * v; }
                        *(u32x4*)(base + (size_t)(ai * HALF + m * 16) * 1024 + bj * HALF) = pack8(o);
                        ss += __shfl_xor(ss, 16); ss += __shfl_xor(ss, 32); mx[bj] = fmaxf(mx[bj], ss); }
            float* km = kmean + (size_t)u.pm * 1024 + ct * 256 + cw;
#pragma unroll
            for (int bj = 0; bj < 2; ++bj)
#pragma unroll
                for (int n = 0; n < 2; ++n)
#pragma unroll
                    for (int j = 0; j < 4; ++j) { float cs = 0.f;
#pragma unroll
                        for (int ai = 0; ai < 2; ++ai)
#pragma unroll
                            for (int m = 0; m < 4; ++m) cs += acc[ai][bj][m][n][j];
                        cs += __shfl_xor(cs, 1); cs += __shfl_xor(cs, 2); cs += __shfl_xor(cs, 4); cs += __shfl_xor(cs, 8);
                        if (fr == 0) atomicAdd(km + bj * HALF + 4 * n + j, cs); }
#pragma unroll
            for (int bj = 0; bj < 2; ++bj) { float v = mx[bj];
                v = fmaxf(v, __shfl_xor(v, 1)); v = fmaxf(v, __shfl_xor(v, 2)); v = fmaxf(v, __shfl_xor(v, 4)); v = fmaxf(v, __shfl_xor(v, 8));
                if (fr == 0 && fq == 0) atomicMax(khmax + (u.pm >> 5) * 32 + ct * 8 + bj * 4 + wc, __float_as_uint(sqrtf(v))); }
        } else {
#pragma unroll
            for (int ai = 0; ai < 2; ++ai)
#pragma unroll
                for (int m = 0; m < 4; ++m)
#pragma unroll
                    for (int bj = 0; bj < 2; ++bj) { float o[8];
#pragma unroll
                        for (int n = 0; n < 2; ++n)
#pragma unroll
                            for (int j = 0; j < 4; ++j) { const float v = acc[ai][bj][m][n][j]; o[4 * n + j] = kind == 1 ? v * QSCALE : kind == 4 ? sigm(v) : v; }
                        *(u32x4*)(base + (size_t)(ai * HALF + m * 16) * 1024 + bj * HALF) = pack8(o); }
        }
    }
};
struct EpiResid {
    static constexpr bool PERM = true, AFTER_DRAIN = false;
    const float* base; float* out; bf16_t* outb; float* ss;
    __device__ __forceinline__ void operator()(const f32x4 (&acc)[2][2][4][2], const Unit& u, int wr, int wc, int fr, int fq) const {
        const int row0 = u.pm * BM + wr * 64 + fr, col0 = u.pn * BM + wc * 32 + 8 * fq;
#pragma unroll
        for (int ai = 0; ai < 2; ++ai)
#pragma unroll
            for (int m = 0; m < 4; ++m) { const size_t off = (size_t)(row0 + ai * HALF + m * 16) * 1024 + col0; float s = 0.f;
#pragma unroll
                for (int bj = 0; bj < 2; ++bj) { const f32x4 b0 = *(const f32x4*)(base + off + bj * HALF), b1 = *(const f32x4*)(base + off + bj * HALF + 4);
                    const f32x4 v0 = acc[ai][bj][m][0] + b0, v1 = acc[ai][bj][m][1] + b1;
                    *(f32x4*)(out + off + bj * HALF) = v0; *(f32x4*)(out + off + bj * HALF + 4) = v1;
                    const float o[8] = {v0[0], v0[1], v0[2], v0[3], v1[0], v1[1], v1[2], v1[3]};
                    *(u32x4*)(outb + off + bj * HALF) = pack8(o);
#pragma unroll
                    for (int j = 0; j < 8; ++j) s += o[j] * o[j]; }
                s += __shfl_xor(s, 16); s += __shfl_xor(s, 32);
                if (fq == 0) atomicAdd(ss + row0 + ai * HALF + m * 16, s);
                asm volatile("" ::: "memory"); }
    }
};
struct EpiFF1 {
    static constexpr bool PERM = true, AFTER_DRAIN = false;
    bf16_t* O; const float* ss; float eps;
    __device__ __forceinline__ void operator()(const f32x4 (&acc)[2][2][4][2], const Unit& u, int wr, int wc, int fr, int fq) const {
        const int row0 = u.pm * BM + wr * 64 + fr, col0 = u.pn * BM + wc * 32 + 8 * fq;
#pragma unroll
        for (int ai = 0; ai < 2; ++ai)
#pragma unroll
            for (int m = 0; m < 4; ++m) { const int row = row0 + ai * HALF + m * 16; const float rs = 1.0f / sqrtf(ss[row] * (1.0f / 1024.0f) + eps);
#pragma unroll
                for (int bj = 0; bj < 2; ++bj) { float o[8];
#pragma unroll
                    for (int n = 0; n < 2; ++n)
#pragma unroll
                        for (int j = 0; j < 4; ++j) { const float v = fmaxf(acc[ai][bj][m][n][j] * rs, 0.f); o[4 * n + j] = v * v; }
                    *(u32x4*)(O + (size_t)row * 4096 + col0 + bj * HALF) = pack8(o); } }
    }
};
struct EpiStore {
    static constexpr bool PERM = true, AFTER_DRAIN = false;
    bf16_t* O;
    __device__ __forceinline__ void operator()(const f32x4 (&acc)[2][2][4][2], const Unit& u, int wr, int wc, int fr, int fq) const {
        const int row0 = u.pm * BM + wr * 64 + fr, col0 = u.pn * BM + wc * 32 + 8 * fq;
#pragma unroll
        for (int ai = 0; ai < 2; ++ai)
#pragma unroll
            for (int m = 0; m < 4; ++m)
#pragma unroll
                for (int bj = 0; bj < 2; ++bj) { float o[8];
#pragma unroll
                    for (int n = 0; n < 2; ++n)
#pragma unroll
                        for (int j = 0; j < 4; ++j) o[4 * n + j] = acc[ai][bj][m][n][j];
                    *(u32x4*)(O + (size_t)(row0 + ai * HALF + m * 16) * 1024 + col0 + bj * HALF) = pack8(o); }
    }
};
struct EpiPle {
    static constexpr bool PERM = true, AFTER_DRAIN = false;
    float* X; const bf16_t* PP; const float* ssin; float* ssout; float eps;
    __device__ __forceinline__ void operator()(const f32x4 (&acc)[2][2][4][2], const Unit& u, int wr, int wc, int fr, int fq) const {
        const int row0 = u.pm * BM + wr * 64 + fr, col0 = u.pn * BM + wc * 32 + 8 * fq;
#pragma unroll
        for (int ai = 0; ai < 2; ++ai)
#pragma unroll
            for (int m = 0; m < 4; ++m) { const int row = row0 + ai * HALF + m * 16; const size_t off = (size_t)row * 1024 + col0; const float rs = 1.0f / sqrtf(ssin[row] * (1.0f / 1024.0f) + eps); float s = 0.f;
#pragma unroll
                for (int bj = 0; bj < 2; ++bj) { const f32x4 b0 = *(const f32x4*)(X + off + bj * HALF), b1 = *(const f32x4*)(X + off + bj * HALF + 4);
                    const u32x4 pw = *(const u32x4*)(PP + off + bj * HALF);
                    const float pp[8] = {__uint_as_float(pw.x << 16), __uint_as_float(pw.x & 0xffff0000u), __uint_as_float(pw.y << 16), __uint_as_float(pw.y & 0xffff0000u),
                                         __uint_as_float(pw.z << 16), __uint_as_float(pw.z & 0xffff0000u), __uint_as_float(pw.w << 16), __uint_as_float(pw.w & 0xffff0000u)};
                    f32x4 v0, v1;
#pragma unroll
                    for (int j = 0; j < 4; ++j) { v0[j] = b0[j] + sigm(acc[ai][bj][m][0][j] * rs) * pp[j]; v1[j] = b1[j] + sigm(acc[ai][bj][m][1][j] * rs) * pp[4 + j]; }
                    *(f32x4*)(X + off + bj * HALF) = v0; *(f32x4*)(X + off + bj * HALF + 4) = v1;
#pragma unroll
                    for (int j = 0; j < 4; ++j) s += v0[j] * v0[j] + v1[j] * v1[j]; }
                s += __shfl_xor(s, 16); s += __shfl_xor(s, 32);
                if (fq == 0) atomicAdd(ssout + row, s);
                asm volatile("" ::: "memory"); }
    }
};

template <class Epi, class Sched, bool ALIGN_EPI = false, bool SP2 = false>
__device__ __forceinline__ void gemm_phase(PG8_LAS unsigned char* lds, const Gemm g, const Sched& S, const Epi& E) {
    const int tid = threadIdx.x, wid = __builtin_amdgcn_readfirstlane(tid >> 6), lane = tid & 63, wr = wid >> 2, wc = wid & 3, fr = lane & 15, fq = lane >> 4;
    const int K = g.K, nt = K / BK;
    unsigned voffA[2], voffB[2];
#pragma unroll
    for (int i = 0; i < 2; ++i) { int R, C; stage_rc(tid * 16 + i * 8192, R, C); const int Rb = Epi::PERM ? ((R & ~31) + perm32(R & 31)) : R;
        voffA[i] = (unsigned)(R * K + C) * 2u; voffB[i] = (unsigned)(Rb * K + C) * 2u; }
    const size_t kstep = (size_t)(BK * 2);
    const size_t hstep = (size_t)HALF * K * 2;
    const size_t tstep = 2 * hstep;
    const unsigned ldsw = (unsigned)wid * 1024u;
    const int aoff = lds_byte(wr * 64 + fr, fq * 8), boff = lds_byte(wc * 32 + fr, fq * 8);
#define PG8_SA(b, h) (((b) * 2 + (h)) * HTB)
#define PG8_SB(b, h) ((4 + (b) * 2 + (h)) * HTB)
#define PG8_STAGE(bufoff, gbase, voff) do { _Pragma("unroll") for (int _i = 0; _i < 2; ++_i) \
        __builtin_amdgcn_global_load_lds((const unsigned*)((const char*)(gbase) + (voff)[_i]), (PG8_LAS unsigned*)(lds + (bufoff) + ldsw + _i * 8192), 16, 0, 0); } while (0)
#define PG8_LDA(dst, b, h) do { _Pragma("unroll") for (int m = 0; m < 4; ++m) _Pragma("unroll") for (int k = 0; k < 2; ++k) dst[m][k] = *(const PG8_LAS bf16x8*)(lds + PG8_SA(b, h) + aoff + m * 2048 + k * 1024); } while (0)
#define PG8_LDB(dst, b, h) do { _Pragma("unroll") for (int n = 0; n < 2; ++n) _Pragma("unroll") for (int k = 0; k < 2; ++k) dst[n][k] = *(const PG8_LAS bf16x8*)(lds + PG8_SB(b, h) + boff + n * 2048 + k * 1024); } while (0)
#define PG8_MMA(ai, bj, At, Bt) do { __builtin_amdgcn_s_setprio(1); _Pragma("unroll") for (int m = 0; m < 4; ++m) _Pragma("unroll") for (int n = 0; n < 2; ++n) _Pragma("unroll") for (int k = 0; k < 2; ++k) \
        acc[ai][bj][m][n] = __builtin_amdgcn_mfma_f32_16x16x32_bf16(Bt[n][k], At[m][k], acc[ai][bj][m][n], 0, 0, 0); __builtin_amdgcn_s_setprio(0); } while (0)
#define PG8_WAIT_V(n) asm volatile("s_waitcnt vmcnt(" #n ")" ::: "memory")
#define PG8_WAIT_L(n) asm volatile("s_waitcnt lgkmcnt(" #n ")" ::: "memory")
#define PG8_BAR __builtin_amdgcn_s_barrier()
#define PG8_SCHED __builtin_amdgcn_sched_barrier(0)
    Unit cur, nxt; int ui = 0;
    if (!S.next(0, cur)) return;
    f32x4 acc[2][2][4][2];
#pragma unroll
    for (int a = 0; a < 2; ++a)
#pragma unroll
        for (int b = 0; b < 2; ++b)
#pragma unroll
            for (int m = 0; m < 4; ++m)
#pragma unroll
                for (int n = 0; n < 2; ++n) acc[a][b][m][n] = (f32x4){0.f, 0.f, 0.f, 0.f};
    bf16x8 At[4][2], B0[2][2], B1[2][2];
    const char* cA = (const char*)g.A + (size_t)cur.pm * tstep; const char* cB = (const char*)g.Bt + (size_t)cur.pn * tstep;
    S.a_ready(cur);
    if constexpr (SP2) {
        PG8_STAGE(PG8_SB(0, 0), cB, voffB); PG8_STAGE(PG8_SB(0, 1), cB + hstep, voffB); PG8_STAGE(PG8_SA(0, 0), cA, voffA); PG8_STAGE(PG8_SA(0, 1), cA + hstep, voffA);
        if (wr == 1) PG8_BAR;
        PG8_WAIT_V(2); PG8_BAR;
        PG8_STAGE(PG8_SB(1, 0), cB + kstep, voffB); PG8_STAGE(PG8_SA(1, 0), cA + kstep, voffA); PG8_STAGE(PG8_SB(1, 1), cB + hstep + kstep, voffB);
        PG8_WAIT_V(6); PG8_BAR;
    } else {
        PG8_STAGE(PG8_SB(0, 0), cB, voffB); PG8_STAGE(PG8_SA(0, 0), cA, voffA); PG8_STAGE(PG8_SB(0, 1), cB + hstep, voffB); PG8_STAGE(PG8_SA(0, 1), cA + hstep, voffA);
        if (wr == 1) PG8_BAR;
        PG8_WAIT_V(4); PG8_BAR;
        PG8_STAGE(PG8_SB(1, 0), cB + kstep, voffB); PG8_STAGE(PG8_SA(1, 0), cA + kstep, voffA); PG8_STAGE(PG8_SB(1, 1), cB + hstep + kstep, voffB);
        PG8_WAIT_V(6); PG8_BAR;
    }
    for (;;) {
        const bool has_next = S.next(ui + 1, nxt);
        const char* nA = has_next ? (const char*)g.A + (size_t)nxt.pm * tstep : cA; const char* nB = has_next ? (const char*)g.Bt + (size_t)nxt.pn * tstep : cB;
        for (int t = 0; t < nt; t += 2) {
            const bool last = (t == nt - 2);
            const char* a1 = cA + (size_t)(t + 1) * kstep;
            const char* a2 = last ? nA : cA + (size_t)(t + 2) * kstep; const char* b2 = last ? nB : cB + (size_t)(t + 2) * kstep;
            const char* a3 = a2 + kstep; const char* b3 = b2 + kstep;
            if (last && has_next) S.a_ready(nxt);
            if constexpr (SP2) {
            PG8_LDB(B0, 0, 0); PG8_LDB(B1, 0, 1); PG8_SCHED; PG8_LDA(At, 0, 0); PG8_STAGE(PG8_SA(1, 1), a1 + hstep, voffA);
            PG8_WAIT_V(8); PG8_WAIT_L(0); PG8_BAR; PG8_MMA(0, 0, At, B0); PG8_MMA(0, 1, At, B1); PG8_BAR; PG8_SCHED;
            PG8_LDA(At, 0, 1); PG8_STAGE(PG8_SB(0, 0), b2, voffB); PG8_STAGE(PG8_SB(0, 1), b2 + hstep, voffB); PG8_STAGE(PG8_SA(0, 0), a2, voffA);
            PG8_WAIT_V(8); PG8_WAIT_L(0); PG8_BAR; PG8_MMA(1, 0, At, B0); PG8_MMA(1, 1, At, B1); PG8_BAR; PG8_SCHED;
            PG8_LDB(B0, 1, 0); PG8_LDB(B1, 1, 1); PG8_SCHED; PG8_LDA(At, 1, 0); PG8_STAGE(PG8_SA(0, 1), a2 + hstep, voffA);
            PG8_WAIT_V(8); PG8_WAIT_L(0); PG8_BAR; PG8_MMA(0, 0, At, B0); PG8_MMA(0, 1, At, B1); PG8_BAR; PG8_SCHED;
            PG8_LDA(At, 1, 1); PG8_STAGE(PG8_SB(1, 0), b3, voffB); PG8_STAGE(PG8_SB(1, 1), b3 + hstep, voffB); PG8_STAGE(PG8_SA(1, 0), a3, voffA);
            PG8_WAIT_V(8); PG8_WAIT_L(0); PG8_BAR; PG8_MMA(1, 0, At, B0); PG8_MMA(1, 1, At, B1); PG8_BAR; PG8_SCHED;
            } else {
            PG8_LDB(B0, 0, 0); PG8_SCHED; PG8_LDA(At, 0, 0); PG8_STAGE(PG8_SA(1, 1), a1 + hstep, voffA);
            PG8_WAIT_L(8); PG8_BAR; PG8_WAIT_L(0); PG8_MMA(0, 0, At, B0); PG8_BAR; PG8_SCHED;
            PG8_LDB(B1, 0, 1); PG8_STAGE(PG8_SB(0, 0), b2, voffB);
            PG8_BAR; PG8_WAIT_L(0); PG8_MMA(0, 1, At, B1); PG8_BAR;
            PG8_LDA(At, 0, 1); PG8_STAGE(PG8_SA(0, 0), a2, voffA);
            PG8_BAR; PG8_WAIT_L(0); PG8_MMA(1, 0, At, B0); PG8_BAR; PG8_SCHED;
            PG8_STAGE(PG8_SB(0, 1), b2 + hstep, voffB);
            PG8_WAIT_V(6); PG8_BAR; PG8_MMA(1, 1, At, B1); PG8_BAR;
            PG8_LDB(B0, 1, 0); PG8_SCHED; PG8_LDA(At, 1, 0); PG8_STAGE(PG8_SA(0, 1), a2 + hstep, voffA);
            PG8_WAIT_L(8); PG8_BAR; PG8_WAIT_L(0); PG8_MMA(0, 0, At, B0); PG8_BAR; PG8_SCHED;
            PG8_LDB(B1, 1, 1); PG8_STAGE(PG8_SB(1, 0), b3, voffB);
            PG8_BAR; PG8_WAIT_L(0); PG8_MMA(0, 1, At, B1); PG8_BAR;
            PG8_LDA(At, 1, 1); PG8_STAGE(PG8_SA(1, 0), a3, voffA);
            PG8_BAR; PG8_WAIT_L(0); PG8_MMA(1, 0, At, B0); PG8_BAR; PG8_SCHED;
            PG8_STAGE(PG8_SB(1, 1), b3 + hstep, voffB);
            PG8_WAIT_V(6); PG8_BAR; PG8_MMA(1, 1, At, B1); PG8_BAR;
            }
        }
        if constexpr (ALIGN_EPI) { if (wr == 0) PG8_BAR; }
        if constexpr (!Epi::AFTER_DRAIN) { E(acc, cur, wr, wc, fr, fq); S.done(cur); }
        if (!has_next) break;
#pragma unroll
        for (int a = 0; a < 2; ++a)
#pragma unroll
            for (int b = 0; b < 2; ++b)
#pragma unroll
                for (int m = 0; m < 4; ++m)
#pragma unroll
                    for (int n = 0; n < 2; ++n) acc[a][b][m][n] = (f32x4){0.f, 0.f, 0.f, 0.f};
        cur = nxt; cA = nA; cB = nB; ++ui;
        if constexpr (ALIGN_EPI) { if (wr == 1) PG8_BAR; }
    }
    PG8_WAIT_V(0);
    if constexpr (!ALIGN_EPI) { if (wr == 0) PG8_BAR; }
    PG8_BAR;
    if constexpr (Epi::AFTER_DRAIN) { E.fused(acc, cur, wr, wc, fr, fq, lds, wid, lane); S.done(cur); }
#undef PG8_SA
#undef PG8_SB
#undef PG8_STAGE
#undef PG8_LDA
#undef PG8_LDB
#undef PG8_MMA
#undef PG8_WAIT_V
#undef PG8_WAIT_L
#undef PG8_BAR
#undef PG8_SCHED
}
}
#define GAS __attribute__((address_space(1)))
#define LAS __attribute__((address_space(3)))
typedef unsigned short bf16;
typedef unsigned v4u __attribute__((ext_vector_type(4)));
typedef float f32x4 __attribute__((ext_vector_type(4)));
typedef short bf16x8 __attribute__((ext_vector_type(8)));
typedef GAS unsigned gu32;
typedef GAS unsigned long long gu64;
#define RLX_AGENT __ATOMIC_RELAXED, __HIP_MEMORY_SCOPE_AGENT
#define LDS_WAIT() asm volatile("s_waitcnt lgkmcnt(0)" ::: "memory")
#define VM_WAIT() asm volatile("s_waitcnt vmcnt(0)" ::: "memory")
__device__ __forceinline__ unsigned long long rt() { return __builtin_amdgcn_s_memrealtime(); }
__device__ __forceinline__ unsigned f2bf(float f) { unsigned u = __builtin_bit_cast(unsigned, f); return (u + 0x7fffu + ((u >> 16) & 1u)) >> 16; }
__device__ __forceinline__ unsigned pk2(float lo, float hi) { return f2bf(lo) | (f2bf(hi) << 16); }

#define XB_TMO      128
#define XB_XCNT(j)  (256  + 64 * (j))
#define XB_XSUB(j)  (1280 + 64 * (j))
#define XB_XGEN(j)  (2304 + 64 * (j))
#define XB_TOP      3328
#define XB_TOPGEN   3392
#define XCD_BAR_WORDS 3456
#define XB_SPIN_CAP (1u << 22)

__device__ __forceinline__ unsigned xb_ld(unsigned* p)              { return __hip_atomic_load(p, __ATOMIC_RELAXED, __HIP_MEMORY_SCOPE_AGENT); }
__device__ __forceinline__ unsigned xb_add(unsigned* p, unsigned v) { return __hip_atomic_fetch_add(p, v, __ATOMIC_RELAXED, __HIP_MEMORY_SCOPE_AGENT); }
__device__ __forceinline__ unsigned xb_xcc_id() { return (unsigned)__builtin_amdgcn_s_getreg((3 << 11) | 20) & 0xFu; }
#define XB_SPIN(cond, bar) do { unsigned _sp = 0; while (cond) { __builtin_amdgcn_s_sleep(1); \
    if ((++_sp & 255u) == 0u) { if (xb_ld(&(bar)[XB_TMO])) break; if (_sp > XB_SPIN_CAP) { atomicAdd(&(bar)[XB_TMO], 1u); break; } } } } while (0)

struct XcdBarrier {
    unsigned* bar; unsigned x;
    volatile LAS unsigned* st;
};

__device__ __forceinline__ XcdBarrier xcd_barrier_post(unsigned* bar, volatile LAS unsigned* st) {
    XcdBarrier b; b.bar = bar; b.x = xb_xcc_id(); b.st = st;
    if (threadIdx.x == 0) (void)xb_add(&bar[XB_XCNT(b.x)], 1u);
    return b;
}
__device__ __forceinline__ void xcd_barrier_complete(unsigned* bar, unsigned x, unsigned& nloc, unsigned& nx) {
    const unsigned G = gridDim.x * gridDim.y * gridDim.z;
    unsigned sum, cnt, mine, sp = 0u;
    for (;;) {
        sum = 0u; cnt = 0u; mine = 0u;
#pragma unroll
        for (unsigned j = 0; j < 16; ++j) { const unsigned c = xb_ld(&bar[XB_XCNT(j)]); sum += c; cnt += (c > 0u) ? 1u : 0u; mine = (j == x) ? c : mine; }
        if (sum == G) break;
        __builtin_amdgcn_s_sleep(1);
        if ((++sp & 255u) == 0u) { if (xb_ld(&bar[XB_TMO])) break; if (sp > XB_SPIN_CAP) { atomicAdd(&bar[XB_TMO], 1u); break; } }
    }
    nloc = mine > 0u ? mine : 1u; nx = cnt > 0u ? cnt : 1u;
}

__device__ __forceinline__ void xcd_barrier(const XcdBarrier& b) {
    asm volatile("s_waitcnt vmcnt(0)" ::: "memory");
    __syncthreads();
    if (threadIdx.x == 0) {
        unsigned* bar = b.bar;
        __builtin_amdgcn_s_waitcnt(0);
        unsigned nloc = b.st[0], nx = b.st[1];
        if (nloc == 0u) { xcd_barrier_complete(bar, b.x, nloc, nx); b.st[0] = nloc; b.st[1] = nx; }
        const unsigned old = xb_add(&bar[XB_XSUB(b.x)], 1u);
        const unsigned gen = old / nloc;
        if (old + 1u == (gen + 1u) * nloc) {
            __builtin_amdgcn_fence(__ATOMIC_RELEASE, "agent");
            asm volatile("s_waitcnt vmcnt(0)" ::: "memory");
            const unsigned og = xb_add(&bar[XB_TOP], 1u);
            const unsigned tg = og / nx;
            if (og + 1u == (tg + 1u) * nx) xb_add(&bar[XB_TOPGEN], 1u);
            else XB_SPIN(xb_ld(&bar[XB_TOPGEN]) == tg, bar);
            __builtin_amdgcn_fence(__ATOMIC_ACQUIRE, "agent");
            xb_add(&bar[XB_XGEN(b.x)], 1u);
            asm volatile("s_waitcnt vmcnt(0)" ::: "memory");
        } else {
            XB_SPIN(xb_ld(&bar[XB_XGEN(b.x)]) == gen, bar);
            __builtin_amdgcn_fence(__ATOMIC_ACQUIRE, "agent");
            asm volatile("s_waitcnt vmcnt(0)" ::: "memory");
        }
    }
    __syncthreads();
}

constexpr int NWAVES = 8;
constexpr int BATCH = 2, SEQ = 8192, D = 1024, H = 16, HD = 64, FF = 4096, PLE = 256, NIN = 7168;
constexpr int M = BATCH * SEQ;
constexpr float EPS = 1e-6f;
constexpr float LOG2E = 1.4426950408889634f;

constexpr size_t MiB = 1u << 20, KiB = 1u << 10;
constexpr size_t WS_CTL = 0, CTL_ZERO_BYTES = 1 * MiB;
constexpr size_t CT_STATS1 = 0;
constexpr size_t CT_SS2 = 128 * KiB, CT_SS3 = 192 * KiB, CT_SS4 = 256 * KiB;
constexpr size_t CT_KMEAN = 320 * KiB;
constexpr size_t CT_KHMAX = 576 * KiB;
constexpr size_t CT_BAR = 640 * KiB;
constexpr size_t WS_WIN = 1 * MiB, WS_WOUT = 15 * MiB, WS_W1 = 17 * MiB, WS_W2 = 25 * MiB, WS_WG = 33 * MiB, WS_WP = 35 * MiB;
constexpr size_t WS_WM = 35 * MiB + 512 * KiB, WS_LUT = 35 * MiB + 768 * KiB;
constexpr size_t WS_Q = 36 * MiB, WS_K = 68 * MiB, WS_UG = 100 * MiB, WS_VS = 132 * MiB, WS_VA = 164 * MiB, WS_GB = 196 * MiB, WS_PB = 228 * MiB;
constexpr size_t WS_X1 = 36 * MiB;
constexpr size_t WS_A = 100 * MiB;
constexpr size_t WS_END = 256 * MiB;

constexpr int RING_OFF = 0, RING_BYTES = 131072;
constexpr int LDSCTL_OFF = RING_BYTES, MISC_OFF = LDSCTL_OFF + 320;
constexpr int LDS_BYTES = 147456;

struct Frame {
    LAS unsigned char* lds;
    volatile LAS unsigned* MISC;
    unsigned char* ws;
    int tid, lane, wave, vcu, G;
    const float* in[17];
    float* out;
};

__device__ __forceinline__ float wave_sum(float v) {
#pragma unroll
    for (int o = 1; o < 64; o <<= 1) v += __shfl_xor(v, o);
    return v;
}
__device__ __forceinline__ float wave_max(float v) {
#pragma unroll
    for (int o = 1; o < 64; o <<= 1) v = fmaxf(v, __shfl_xor(v, o));
    return v;
}
__device__ __forceinline__ int wave_min_i(int v) {
#pragma unroll
    for (int o = 1; o < 64; o <<= 1) { const int t = __shfl_xor(v, o); v = t < v ? t : v; }
    return v;
}
__device__ __forceinline__ float bflo(unsigned w) { return __uint_as_float(w << 16); }
__device__ __forceinline__ float bfhi(unsigned w) { return __uint_as_float(w & 0xffff0000u); }

__device__ __forceinline__ int win_rowmap(int c) {
    if (c < 1024) return (c >> 7) * 256 + (c & 127);
    if (c < 5120) return c + 1024;
    if (c < 6144) { const int d = c - 5120; return (d >> 7) * 256 + 128 + (d & 127); }
    return c;
}
__device__ __forceinline__ void p0_transpose_item(const float* W, int K, int N, bf16* WT, int dst_row0, int k0, int n0, const float* gk, LAS float* scr, int lane) {
#pragma unroll 8
    for (int i = 0; i < 32; ++i) { const int kk = 2 * i + (lane >> 5); scr[kk * 33 + (lane & 31)] = W[(size_t)(k0 + kk) * N + n0 + (lane & 31)]; }
    LDS_WAIT(); asm volatile("" ::: "memory");
    const int c = lane & 7;
    float g[8];
#pragma unroll
    for (int e = 0; e < 8; ++e) g[e] = gk ? gk[k0 + 8 * c + e] : 1.0f;
#pragma unroll
    for (int j = 0; j < 4; ++j) { const int n = (lane >> 3) + 8 * j; const LAS float* s = scr + (8 * c) * 33 + n;
        v4u o; o.x = pk2(s[0 * 33] * g[0], s[1 * 33] * g[1]); o.y = pk2(s[2 * 33] * g[2], s[3 * 33] * g[3]); o.z = pk2(s[4 * 33] * g[4], s[5 * 33] * g[5]); o.w = pk2(s[6 * 33] * g[6], s[7 * 33] * g[7]);
        *(GAS v4u*)(WT + (size_t)(dst_row0 + n) * K + k0 + 8 * c) = o; }
    LDS_WAIT(); asm volatile("" ::: "memory");
}
__device__ __forceinline__ int rel_bucket(int n) {
    if (n < 16) return n;
    int b = 16;
    b += (n >= 21); b += (n >= 27); b += (n >= 35); b += (n >= 46); b += (n >= 59); b += (n >= 77); b += (n >= 99); b += (n >= 128);
    b += (n >= 166); b += (n >= 216); b += (n >= 280); b += (n >= 363); b += (n >= 470); b += (n >= 609); b += (n >= 790);
    return b;
}
__device__ __forceinline__ void p0_prologue(Frame& F) {
    LAS float* scr = (LAS float*)(F.lds + RING_OFF + F.wave * 16384);
    const int gw = F.vcu * NWAVES + F.wave, NGW = F.G * NWAVES;
    const float *x = F.in[0], *p = F.in[1], *g_mix = F.in[2], *w_in = F.in[3], *w_s = F.in[4], *rel = F.in[8], *w_out = F.in[9], *g_ffn = F.in[10], *w1 = F.in[11], *w2 = F.in[12], *g_ple = F.in[13], *wg = F.in[14], *wp = F.in[15];
    bf16 *Win_t = (bf16*)(F.ws + WS_WIN), *Wout_t = (bf16*)(F.ws + WS_WOUT), *W1_t = (bf16*)(F.ws + WS_W1), *W2_t = (bf16*)(F.ws + WS_W2), *Wg_t = (bf16*)(F.ws + WS_WG), *Wp_t = (bf16*)(F.ws + WS_WP);
    constexpr int I_IN = (D / 64) * (NIN / 32), I_OUT = (D / 64) * (D / 32), I_1 = (D / 64) * (FF / 32), I_2 = (FF / 64) * (D / 32), I_G = I_OUT, I_P = (PLE / 64) * (D / 32);
    constexpr int NITEMS = I_IN + I_OUT + I_1 + I_2 + I_G + I_P;
    for (int it = gw; it < NITEMS; it += NGW) {
        int r = it;
        if (r < I_IN) { const int nb = r % (NIN / 32), kb = r / (NIN / 32); p0_transpose_item(w_in, D, NIN, Win_t, win_rowmap(32 * nb), 64 * kb, 32 * nb, nullptr, scr, F.lane); continue; } r -= I_IN;
        if (r < I_OUT) { const int nb = r % (D / 32), kb = r / (D / 32); p0_transpose_item(w_out, D, D, Wout_t, 32 * nb, 64 * kb, 32 * nb, nullptr, scr, F.lane); continue; } r -= I_OUT;
        if (r < I_1) { const int nb = r % (FF / 32), kb = r / (FF / 32); p0_transpose_item(w1, D, FF, W1_t, 32 * nb, 64 * kb, 32 * nb, g_ffn, scr, F.lane); continue; } r -= I_1;
        if (r < I_2) { const int nb = r % (D / 32), kb = r / (D / 32); p0_transpose_item(w2, FF, D, W2_t, 32 * nb, 64 * kb, 32 * nb, nullptr, scr, F.lane); continue; } r -= I_2;
        if (r < I_G) { const int nb = r % (D / 32), kb = r / (D / 32); p0_transpose_item(wg, D, D, Wg_t, 32 * nb, 64 * kb, 32 * nb, g_ple, scr, F.lane); continue; } r -= I_G;
        { const int nb = r % (D / 32), kb = r / (D / 32); p0_transpose_item(wp, PLE, D, Wp_t, 32 * nb, 64 * kb, 32 * nb, nullptr, scr, F.lane); }
    }
    const int gt = F.vcu * (NWAVES * 64) + F.tid, NGT = F.G * NWAVES * 64;
    { bf16* Wm = (bf16*)(F.ws + WS_WM);
      for (int i = gt; i < 8 * 128 * 128; i += NGT) { const int s = i & 127, t = (i >> 7) & 127; Wm[i] = (bf16)f2bf(s <= t ? w_s[i] : 0.f); } }
    { float* lut = (float*)(F.ws + WS_LUT);
      for (int i = gt; i < 16 * 1024; i += NGT) { const int h = i >> 10, dist = i & 1023; lut[i] = rel[rel_bucket(dist) * 16 + h] * LOG2E; } }
    { bf16* Pb = (bf16*)(F.ws + WS_PB);
      for (int i = gt; i < M * PLE / 8; i += NGT) { const f32x4 a = ((const f32x4*)p)[2 * i], b = ((const f32x4*)p)[2 * i + 1];
        v4u o; o.x = pk2(a.x, a.y); o.y = pk2(a.z, a.w); o.z = pk2(b.x, b.y); o.w = pk2(b.z, b.w); ((v4u*)Pb)[i] = o; } }
    { bf16* Hn = (bf16*)F.out;
      f32x4 gv[4];
#pragma unroll
      for (int j = 0; j < 4; ++j) gv[j] = ((const f32x4*)g_mix)[F.lane + 64 * j];
      for (int m = gw; m < M; m += NGW) { const f32x4* xr = (const f32x4*)(x + (size_t)m * D) + F.lane; f32x4 v[4]; float s = 0.f;
#pragma unroll
        for (int j = 0; j < 4; ++j) { v[j] = xr[64 * j]; s += (v[j].x * v[j].x + v[j].y * v[j].y) + (v[j].z * v[j].z + v[j].w * v[j].w); }
        const float rs = 1.0f / sqrtf(wave_sum(s) * (1.0f / D) + EPS);
        unsigned long long* o8 = (unsigned long long*)(Hn + (size_t)m * D) + F.lane;
#pragma unroll
        for (int j = 0; j < 4; ++j) o8[64 * j] = (unsigned long long)pk2(v[j].x * rs * gv[j].x, v[j].y * rs * gv[j].y) | ((unsigned long long)pk2(v[j].z * rs * gv[j].z, v[j].w * rs * gv[j].w) << 32); } }
}

__device__ __forceinline__ void attn_simple(Frame& F) {
    LAS float* pbuf = (LAS float*)(F.lds + RING_OFF) + F.wave * 1024;
    const int gw = F.vcu * NWAVES + F.wave, NGW = F.G * NWAVES, lane = F.lane;
    const bf16 *Q = (const bf16*)(F.ws + WS_Q), *K = (const bf16*)(F.ws + WS_K), *VA = (const bf16*)(F.ws + WS_VA);
    const float *kmean = (const float*)(F.ws + WS_CTL + CT_KMEAN), *lut = (const float*)(F.ws + WS_LUT);
    bf16* YB = (bf16*)((unsigned char*)F.out + 32 * MiB);
    for (int item = gw; item < BATCH * H * SEQ; item += NGW) {
        const int t = item & (SEQ - 1), bh = item >> 13, b = bh >> 4, h = bh & 15, own = t >> 8;
        const size_t rowq = (size_t)b * SEQ + t;
        float q[64];
        { const v4u* qp = (const v4u*)(Q + rowq * D + h * HD);
#pragma unroll
          for (int i = 0; i < 8; ++i) { const v4u w = qp[i]; q[8 * i] = bflo(w.x); q[8 * i + 1] = bfhi(w.x); q[8 * i + 2] = bflo(w.y); q[8 * i + 3] = bfhi(w.y); q[8 * i + 4] = bflo(w.z); q[8 * i + 5] = bfhi(w.z); q[8 * i + 6] = bflo(w.w); q[8 * i + 7] = bfhi(w.w); } }
        float g = -INFINITY;
        if (lane < own) { const f32x4* km = (const f32x4*)(kmean + (size_t)(b * 32 + lane) * D + h * HD); float a = 0.f;
#pragma unroll
            for (int i = 0; i < 16; ++i) { const f32x4 kv = km[i]; a += q[4 * i] * kv.x + q[4 * i + 1] * kv.y + q[4 * i + 2] * kv.z + q[4 * i + 3] * kv.w; }
            g = a; }
        int sel[3];
#pragma unroll
        for (int r = 0; r < 3; ++r) { const float mg = wave_max(g); int idx = (g == mg && mg > -INFINITY) ? lane : 64; idx = wave_min_i(idx); sel[r] = idx; if (lane == idx) g = -INFINITY; }
        float sv[4][4]; float mx = -INFINITY;
#pragma unroll
        for (int blk = 0; blk < 4; ++blk) { const int n = blk < 3 ? sel[blk] : own;
#pragma unroll
            for (int kg = 0; kg < 4; ++kg) { float s = -INFINITY;
                if (n < 64) { const int kpos = n * 256 + kg * 64 + lane; const v4u* kp = (const v4u*)(K + ((size_t)b * SEQ + kpos) * D + h * HD); float a = 0.f;
#pragma unroll
                    for (int i = 0; i < 8; ++i) { const v4u w = kp[i]; a += q[8 * i] * bflo(w.x) + q[8 * i + 1] * bfhi(w.x) + q[8 * i + 2] * bflo(w.y) + q[8 * i + 3] * bfhi(w.y) + q[8 * i + 4] * bflo(w.z) + q[8 * i + 5] * bfhi(w.z) + q[8 * i + 6] * bflo(w.w) + q[8 * i + 7] * bfhi(w.w); }
                    const int dist = t - kpos; if (dist >= 0) s = a + lut[h * 1024 + (dist < 1023 ? dist : 1023)]; }
                sv[blk][kg] = s; mx = fmaxf(mx, s); } }
        mx = wave_max(mx);
        float l = 0.f;
#pragma unroll
        for (int blk = 0; blk < 4; ++blk)
#pragma unroll
            for (int kg = 0; kg < 4; ++kg) { const float pe = __builtin_amdgcn_exp2f(sv[blk][kg] - mx); l += pe; pbuf[blk * 256 + kg * 64 + lane] = pe; }
        l = wave_sum(l);
        LDS_WAIT(); asm volatile("" ::: "memory");
        float o = 0.f;
#pragma unroll
        for (int blk = 0; blk < 4; ++blk) { const int n = blk < 3 ? sel[blk] : own;
            if (n < 64) { const bf16* vp = VA + ((size_t)b * SEQ + n * 256) * D + h * HD + lane;
#pragma unroll 8
                for (int key = 0; key < 256; ++key) o += pbuf[blk * 256 + key] * __uint_as_float((unsigned)vp[(size_t)key * D] << 16); } }
        YB[rowq * D + h * HD + lane] = (bf16)f2bf(o / l);
        LDS_WAIT(); asm volatile("" ::: "memory");
    }
}
__device__ __forceinline__ void sgu_simple(Frame& F) {
    LAS float* vn = (LAS float*)(F.lds + RING_OFF);
    const bf16 *UG = (const bf16*)(F.ws + WS_UG), *VS = (const bf16*)(F.ws + WS_VS), *GB = (const bf16*)(F.ws + WS_GB), *YB = (const bf16*)((unsigned char*)F.out + 32 * MiB);
    bf16* MG = (bf16*)F.out;
    const float *stats = (const float*)(F.ws + WS_CTL + CT_STATS1), *w_s = F.in[4], *b_s = F.in[5], *lng = F.in[6], *lnb = F.in[7];
    const int ch = F.tid & 255, th = __builtin_amdgcn_readfirstlane(F.tid >> 8);
    for (int item = F.vcu; item < (M / 128) * 4; item += F.G) {
        const int c = item >> 2, qd = item & 3, col = 256 * qd + ch;
        __syncthreads();
        { const float lg = lng[col], lb = lnb[col];
          for (int s = th; s < 128; s += 2) { const size_t row = (size_t)c * 128 + s; const float s1 = stats[2 * row], s2 = stats[2 * row + 1];
            const float mu = s1 * (1.0f / 1024.0f), var = fmaxf(s2 * (1.0f / 1024.0f) - mu * mu, 0.f), rs = 1.0f / sqrtf(var + EPS);
            vn[s * 256 + ch] = (__uint_as_float((unsigned)VS[row * D + col] << 16) - mu) * rs * lg + lb; } }
        __syncthreads();
        const int g = __builtin_amdgcn_readfirstlane(col >> 7);
        for (int tt = 0; tt < 64; ++tt) { const int t = 64 * th + tt; const float* wr_ = w_s + ((size_t)g * 128 + t) * 128; float a = 0.f;
            for (int s = 0; s <= t; ++s) a += wr_[s] * vn[s * 256 + ch];
            const float mixed = a + b_s[g * 128 + t];
            const size_t off = ((size_t)c * 128 + t) * D + col;
            const float ug = __uint_as_float((unsigned)UG[off] << 16), gb = __uint_as_float((unsigned)GB[off] << 16), yb = __uint_as_float((unsigned)YB[off] << 16);
            MG[off] = (bf16)f2bf(ug * mixed + gb * yb); }
    }
    __syncthreads();
}
__device__ __forceinline__ void final_norm(Frame& F) {
    const float *X3 = (const float*)(F.ws + WS_X1), *ss4 = (const float*)(F.ws + WS_CTL + CT_SS4), *gf = F.in[16];
    const int gw = F.vcu * NWAVES + F.wave, NGW = F.G * NWAVES;
    f32x4 gv[4];
#pragma unroll
    for (int j = 0; j < 4; ++j) gv[j] = ((const f32x4*)gf)[F.lane + 64 * j];
    for (int m = gw; m < M; m += NGW) { const float rs = 1.0f / sqrtf(ss4[m] * (1.0f / D) + EPS);
        const f32x4* xr = (const f32x4*)(X3 + (size_t)m * D) + F.lane; f32x4* o = (f32x4*)(F.out + (size_t)m * D) + F.lane;
#pragma unroll
        for (int j = 0; j < 4; ++j) o[64 * j] = xr[64 * j] * rs * gv[j]; }
}

#ifndef MK_N_LAUNCHES
#define MK_N_LAUNCHES 1
#endif
constexpr int N_PHASES = 9;
struct Args { const float* in[17]; float* out; unsigned char* ws; int ph_lo, ph_hi; };
__global__ void __launch_bounds__(NWAVES * 64, 2) mk_fwd(Args args) {
    extern __shared__ __attribute__((aligned(16))) unsigned char lds[];
    Frame F;
    F.lds = (LAS unsigned char*)lds; F.MISC = (volatile LAS unsigned*)(F.lds + MISC_OFF);
    F.tid = threadIdx.x; F.lane = F.tid & 63; F.wave = __builtin_amdgcn_readfirstlane(F.tid >> 6);
    F.G = gridDim.x; { const int bx = blockIdx.x; F.vcu = (F.G % 8 == 0) ? (bx % 8) * (F.G / 8) + bx / 8 : bx; }
    F.ws = args.ws; F.out = args.out;
#pragma unroll
    for (int i = 0; i < 17; ++i) F.in[i] = args.in[i];
    for (int u = F.tid; u < (LDS_BYTES - LDSCTL_OFF) / 4; u += NWAVES * 64) ((LAS unsigned*)(F.lds + LDSCTL_OFF))[u] = 0u;
    __syncthreads();
    unsigned* barw = (unsigned*)(F.ws + WS_CTL + CT_BAR);
    XcdBarrier bar; bar.bar = barw; bar.x = 0; bar.st = nullptr;
    if (MK_N_LAUNCHES == 1) bar = xcd_barrier_post(barw, F.MISC + 8);
    const int lo = args.ph_lo, hi = args.ph_hi;
#define IN(k) (lo <= (k) && (k) < hi)
#define SEAM(k) do { if (IN(k) && IN((k) + 1)) xcd_barrier(bar); } while (0)
    float* ctl = (float*)(F.ws + WS_CTL);
    bf16* d0 = (bf16*)F.out; bf16* d1 = (bf16*)((unsigned char*)F.out + 32 * MiB);
    if (IN(0)) { p0_prologue(F); } SEAM(0);
    if (IN(1)) {
        pg8::Gemm g{d0, (const bf16*)(F.ws + WS_WIN), M, NIN, D}; pg8::StaticOrder S; S.init(M, NIN, F.G, (int)blockIdx.x);
        pg8::EpiIn E{(bf16*)(F.ws + WS_UG), (bf16*)(F.ws + WS_VS), (bf16*)(F.ws + WS_Q), (bf16*)(F.ws + WS_K), (bf16*)(F.ws + WS_VA), (bf16*)(F.ws + WS_GB),
                     (float*)(F.ws + WS_CTL + CT_STATS1), (float*)(F.ws + WS_CTL + CT_KMEAN), (unsigned*)(F.ws + WS_CTL + CT_KHMAX)};
        pg8::gemm_phase<pg8::EpiIn, pg8::StaticOrder, true, true>(F.lds + RING_OFF, g, S, E);
    } SEAM(1);
    if (IN(2)) { attn_simple(F); } SEAM(2);
    if (IN(3)) { sgu_simple(F); } SEAM(3);
    if (IN(4)) {
        pg8::Gemm g{d0, (const bf16*)(F.ws + WS_WOUT), M, D, D}; pg8::StaticOrder S; S.init(M, D, F.G, (int)blockIdx.x);
        pg8::EpiResid E{F.in[0], (float*)(F.ws + WS_X1), d1, (float*)(F.ws + WS_CTL + CT_SS2)};
        pg8::gemm_phase<pg8::EpiResid, pg8::StaticOrder, true, true>(F.lds + RING_OFF, g, S, E);
    } SEAM(4);
    if (IN(5)) {
        pg8::Gemm g{d1, (const bf16*)(F.ws + WS_W1), M, FF, D}; pg8::StaticOrder S; S.init(M, FF, F.G, (int)blockIdx.x);
        pg8::EpiFF1 E{(bf16*)(F.ws + WS_A), (const float*)(F.ws + WS_CTL + CT_SS2), EPS};
        pg8::gemm_phase<pg8::EpiFF1, pg8::StaticOrder, true, true>(F.lds + RING_OFF, g, S, E);
    } SEAM(5);
    if (IN(6)) {
        pg8::Gemm g{(const bf16*)(F.ws + WS_A), (const bf16*)(F.ws + WS_W2), M, D, FF}; pg8::StaticOrder S; S.init(M, D, F.G, (int)blockIdx.x);
        pg8::EpiResid E{(const float*)(F.ws + WS_X1), (float*)(F.ws + WS_X1), d0, (float*)(F.ws + WS_CTL + CT_SS3)};
        pg8::gemm_phase<pg8::EpiResid, pg8::StaticOrder, true, true>(F.lds + RING_OFF, g, S, E);
    } SEAM(6);
    if (IN(7)) {
        { int kple = PLE; asm volatile("" : "+s"(kple));
          pg8::Gemm g{(const bf16*)(F.ws + WS_PB), (const bf16*)(F.ws + WS_WP), M, D, kple}; pg8::StaticOrder S; S.init(M, D, F.G, (int)blockIdx.x);
          pg8::EpiStore E{(bf16*)(F.ws + WS_A)};
          pg8::gemm_phase<pg8::EpiStore, pg8::StaticOrder, true, true>(F.lds + RING_OFF, g, S, E); }
        asm volatile("s_waitcnt vmcnt(0)" ::: "memory"); __syncthreads();
        { pg8::Gemm g{d0, (const bf16*)(F.ws + WS_WG), M, D, D}; pg8::StaticOrder S; S.init(M, D, F.G, (int)blockIdx.x);
          pg8::EpiPle E{(float*)(F.ws + WS_X1), (const bf16*)(F.ws + WS_A), (const float*)(F.ws + WS_CTL + CT_SS3), (float*)(F.ws + WS_CTL + CT_SS4), EPS};
          pg8::gemm_phase<pg8::EpiPle, pg8::StaticOrder, true, true>(F.lds + RING_OFF, g, S, E); }
    } SEAM(7);
    if (IN(8)) { final_norm(F); }
    (void)ctl;
#undef IN
#undef SEAM
}

extern "C" void kernel_launch(void* const* d_in, const int* in_sizes, int n_in, void* d_out, int out_size, void* d_ws, size_t ws_size, hipStream_t stream) {
    static int grid = 0;
    if (grid == 0) {
        if (n_in != 17 || in_sizes[0] != M * D || out_size != M * D || ws_size < WS_END) { fprintf(stderr, "kernel_launch: unexpected shapes (n_in %d, in0 %d, out %d, ws %zu); nothing launched\n", n_in, n_in > 0 ? in_sizes[0] : -1, out_size, ws_size); grid = -1; return; }
        int dev = 0, cus = 0, per_cu = 0;
        if (hipGetDevice(&dev) != hipSuccess || hipDeviceGetAttribute(&cus, hipDeviceAttributeMultiprocessorCount, dev) != hipSuccess) { grid = -1; return; }
        if (hipFuncSetAttribute((const void*)mk_fwd, hipFuncAttributeMaxDynamicSharedMemorySize, LDS_BYTES) != hipSuccess) { fprintf(stderr, "kernel_launch: hipFuncSetAttribute failed\n"); grid = -1; return; }
        if (hipOccupancyMaxActiveBlocksPerMultiprocessor(&per_cu, (const void*)mk_fwd, NWAVES * 64, LDS_BYTES) != hipSuccess || per_cu < 1) fprintf(stderr, "kernel_launch: note: occupancy query reports %d blocks per CU\n", per_cu);
        (void)hipGetLastError();
        grid = cus;
    }
    if (grid < 0) return;
    if (hipMemsetAsync((char*)d_ws + WS_CTL, 0, CTL_ZERO_BYTES, stream) != hipSuccess) { fprintf(stderr, "kernel_launch: memset failed\n"); return; }
    Args a{};
    for (int i = 0; i < 17; ++i) a.in[i] = (const float*)d_in[i];
    a.out = (float*)d_out; a.ws = (unsigned char*)d_ws;
    if (MK_N_LAUNCHES == 1) { a.ph_lo = 0; a.ph_hi = N_PHASES; hipLaunchKernelGGL(mk_fwd, dim3(grid), dim3(NWAVES * 64), LDS_BYTES, stream, a); }
    else for (int ph = 0; ph < N_PHASES; ++ph) { a.ph_lo = ph; a.ph_hi = ph + 1; hipLaunchKernelGGL(mk_fwd, dim3(grid), dim3(NWAVES * 64), LDS_BYTES, stream, a); }
}
```

```cpp
#include <hip/hip_runtime.h>
#include <cstdio>
#include <cstdint>
#include <cmath>
namespace pg8 {
#define PG8_LAS __attribute__((address_space(3)))
typedef unsigned short bf16_t;
typedef short bf16x8 __attribute__((ext_vector_type(8)));
typedef float f32x4 __attribute__((ext_vector_type(4)));
typedef unsigned u32x4 __attribute__((ext_vector_type(4)));
constexpr int BM = 256, BK = 64, HALF = 128, HTB = HALF * BK * 2  , STAGE_BYTES = 8 * HTB, NXCD = 8, WGM = 8;

__host__ __device__ __forceinline__ int lds_byte(int r, int c) { const int st = (r >> 4) * 2 + (c >> 5), rr = r & 15, cc = c & 31, ob = rr * 64 + cc * 2; return st * 1024 + (ob ^ (((ob >> 9) & 1) << 5)); }
__host__ __device__ __forceinline__ void stage_rc(int b, int& R, int& C) { const int st = b / 1024, sb = b % 1024, swz = sb ^ (((sb >> 9) & 1) << 5); R = (st >> 1) * 16 + swz / 64; C = (st & 1) * 32 + (swz % 64) / 2; }
__host__ __device__ __forceinline__ int perm32(int rho) { const int n = rho >> 4, i = rho & 15; return 8 * (i >> 2) + 4 * n + (i & 3); }

struct Unit { int pm, pn; };
struct Gemm { const bf16_t* A; const bf16_t* Bt; int M, N, K; const bf16_t* A2 = nullptr; int pm2 = 1 << 30; };

struct StaticOrder {
    int nM, nN, nwg, G, c;
    __host__ __device__ void init(int M, int N, int G_, int c_) { nM = M / BM; nN = N / BM; nwg = nM * nN; G = G_; c = c_; }
    __host__ __device__ bool next(int i, Unit& u) const {
        const long L = (long)i * G + c; if (L >= nwg) return false;
        int wgid = (int)L; { const int q = nwg / NXCD, r = nwg % NXCD, xcd = wgid % NXCD, off = wgid / NXCD; wgid = (xcd < r ? xcd * (q + 1) : r * (q + 1) + (xcd - r) * q) + off; }
        const int nig = WGM * nN, gid = wgid / nig, fm = gid * WGM, gsz = (nM - fm) < WGM ? (nM - fm) : WGM;
        u.pm = fm + ((wgid % nig) % gsz); u.pn = (wgid % nig) / gsz; return true;
    }
    __device__ __forceinline__ void a_ready(const Unit&) const {}
    __device__ __forceinline__ void done(const Unit&) const {}
};

__device__ __forceinline__ unsigned cvt_pk_bf16(float lo, float hi) { unsigned r; asm volatile("v_cvt_pk_bf16_f32 %0, %1, %2" : "=v"(r) : "v"(lo), "v"(hi)); return r; }
typedef float f32x2 __attribute__((ext_vector_type(2)));
__device__ __forceinline__ f32x2 gelu_pk(f32x2 v) {
    const f32x2 av = __builtin_elementwise_abs(v), d = av * 0.2316418882f + 1.0f;
    f32x2 t; t.x = __builtin_amdgcn_rcpf(d.x); t.y = __builtin_amdgcn_rcpf(d.y);
    f32x2 q = t * 0.5307027145f + (-0.7265760135f); q = q * t + 0.7107068705f; q = q * t + (-0.142248368f); q = q * t + 0.127414796f; q = q * t;
    const f32x2 s = (v * v) * (-0.72134752044f);
    f32x2 e; e.x = __builtin_amdgcn_exp2f(s.x); e.y = __builtin_amdgcn_exp2f(s.y);
    const f32x2 m = v * (q * e), r = v - m;
    f32x2 o; o.x = v.x < 0.f ? m.x : r.x; o.y = v.y < 0.f ? m.y : r.y; return o;
}

template <int ACT  > struct EpiBf16 {
    static constexpr bool PERM = true, AFTER_DRAIN = false; static_assert(ACT == 0 || ACT == 1, "EpiBf16: ACT is 0 (none) or 1 (gelu_pk)");
    bf16_t* O; int ldc; const float* bias; int split_cols; size_t split_stride; float scale0;
    __device__ __forceinline__ void operator()(const f32x4 (&acc)[2][2][4][2], const Unit& u, int wr, int wc, int fr, int fq) const {
        const int row0 = u.pm * BM + wr * 64 + fr; int colt = u.pn * BM; bf16_t* base = O;
        float sc = 1.f; if (split_cols) { const int t = colt / split_cols; base += (size_t)t * split_stride; colt -= t * split_cols; if (t == 0) sc = scale0; }
        const int col0 = colt + wc * 32 + 8 * fq, bcol0 = u.pn * BM + wc * 32 + 8 * fq;
        f32x4 bv[2][2];
#pragma unroll
        for (int bj = 0; bj < 2; ++bj)
#pragma unroll
            for (int n = 0; n < 2; ++n) bv[bj][n] = bias ? *(const f32x4*)(bias + bcol0 + bj * HALF + 4 * n) : (f32x4){0.f, 0.f, 0.f, 0.f};
#pragma unroll
        for (int ai = 0; ai < 2; ++ai)
#pragma unroll
            for (int m = 0; m < 4; ++m) { bf16_t* rowp = base + (size_t)(row0 + ai * HALF + m * 16) * ldc + col0;
#pragma unroll
                for (int bj = 0; bj < 2; ++bj) { f32x4 v0 = acc[ai][bj][m][0] + bv[bj][0], v1 = acc[ai][bj][m][1] + bv[bj][1];
                    if (ACT == 1) { f32x2 a = gelu_pk((f32x2){v0[0], v0[1]}), b = gelu_pk((f32x2){v0[2], v0[3]}), c = gelu_pk((f32x2){v1[0], v1[1]}), d = gelu_pk((f32x2){v1[2], v1[3]});
                        v0 = (f32x4){a.x, a.y, b.x, b.y}; v1 = (f32x4){c.x, c.y, d.x, d.y}; }
                    v0 = v0 * sc; v1 = v1 * sc; u32x4 w; w.x = cvt_pk_bf16(v0[0], v0[1]); w.y = cvt_pk_bf16(v0[2], v0[3]); w.z = cvt_pk_bf16(v1[0], v1[1]); w.w = cvt_pk_bf16(v1[2], v1[3]);
                    *(u32x4*)(rowp + bj * HALF) = w; } }
    }
};

__device__ __forceinline__ float sigm(float x) { return __builtin_amdgcn_rcpf(1.0f + __builtin_amdgcn_exp2f(-1.4426950408889634f * x)); }
__device__ __forceinline__ float gelu_t(float x) { return x * sigm(x * (1.5957691216057308f + 0.07135481627260025f * x * x)); }
__device__ __forceinline__ u32x4 pack8(const float (&o)[8]) { u32x4 w; w.x = cvt_pk_bf16(o[0], o[1]); w.y = cvt_pk_bf16(o[2], o[3]); w.z = cvt_pk_bf16(o[4], o[5]); w.w = cvt_pk_bf16(o[6], o[7]); return w; }
constexpr float QSCALE = 0.125f * 1.4426950408889634f;

struct EpiIn {
    static constexpr bool PERM = true, AFTER_DRAIN = false;
    bf16_t *UG, *VS, *Q, *K, *VA, *GB; float* stats1; float* kmean; unsigned* khmax; PG8_LAS unsigned char* stage;
    __device__ __forceinline__ void operator()(const f32x4 (&acc)[2][2][4][2], const Unit& u, int wr, int wc, int fr, int fq) const {
        const int row0 = u.pm * BM + wr * 64 + fr, cw = wc * 32 + 8 * fq;
        if (u.pn < 8) {
            bf16_t* base = UG + (size_t)row0 * 1024 + u.pn * 128 + cw;
#pragma unroll
            for (int ai = 0; ai < 2; ++ai)
#pragma unroll
                for (int m = 0; m < 4; ++m) { float o[8];
#pragma unroll
                    for (int n = 0; n < 2; ++n)
#pragma unroll
                        for (int j = 0; j < 4; ++j) o[4 * n + j] = gelu_t(acc[ai][0][m][n][j]) * sigm(acc[ai][1][m][n][j]);
                    *(u32x4*)(base + (size_t)(ai * HALF + m * 16) * 1024) = pack8(o); }
            return;
        }
        const int kind = (u.pn - 8) >> 2, ct = (u.pn - 8) & 3;
        bf16_t* base = (kind == 0 ? VS : kind == 1 ? Q : kind == 2 ? K : kind == 3 ? VA : GB) + (size_t)row0 * 1024 + ct * 256 + cw;
        if (kind == 0) {
#pragma unroll
            for (int ai = 0; ai < 2; ++ai)
#pragma unroll
                for (int m = 0; m < 4; ++m) { float s1 = 0.f, s2 = 0.f;
#pragma unroll
                    for (int bj = 0; bj < 2; ++bj) { float o[8];
#pragma unroll
                        for (int n = 0; n < 2; ++n)
#pragma unroll
                            for (int j = 0; j < 4; ++j) { const float g = gelu_t(acc[ai][bj][m][n][j]); o[4 * n + j] = g; s1 += g; s2 += g * g; }
                        *(u32x4*)(base + (size_t)(ai * HALF + m * 16) * 1024 + bj * HALF) = pack8(o); }
                    s1 += __shfl_xor(s1, 16); s1 += __shfl_xor(s1, 32); s2 += __shfl_xor(s2, 16); s2 += __shfl_xor(s2, 32);
                    if (fq == 0) { float* sp = stats1 + 2 * (size_t)(row0 + ai * HALF + m * 16); atomicAdd(sp, s1); atomicAdd(sp + 1, s2); } }
        } else if (kind == 2) {
            float mx[2] = {0.f, 0.f};
            bf16_t* kfb = K + ((size_t)((u.pm >> 5) * 16 + 4 * ct + (wc >> 1)) * 65536 + (size_t)(u.pm & 31) * 2048 + wr * 512 + (2 * (wc & 1) + (fq >> 1)) * 64 + (fq & 1) * 32 + fr) * 8;
#pragma unroll
            for (int ai = 0; ai < 2; ++ai)
#pragma unroll
                for (int m = 0; m < 4; ++m)
#pragma unroll
                    for (int bj = 0; bj < 2; ++bj) { float o[8]; float ss = 0.f;
#pragma unroll
                        for (int n = 0; n < 2; ++n)
#pragma unroll
                            for (int j = 0; j < 4; ++j) { const float v = acc[ai][bj][m][n][j]; o[4 * n + j] = v; ss += v * v; }
                        *(u32x4*)(kfb + (size_t)bj * (2 * 65536 * 8) + (ai * 1024 + (m >> 1) * 256 + (m & 1) * 16) * 8) = pack8(o);
                        ss += __shfl_xor(ss, 16); ss += __shfl_xor(ss, 32); mx[bj] = fmaxf(mx[bj], ss); }
            float* km = kmean + (size_t)u.pm * 1024 + ct * 256 + cw;
#pragma unroll
            for (int bj = 0; bj < 2; ++bj)
#pragma unroll
                for (int n = 0; n < 2; ++n)
#pragma unroll
                    for (int j = 0; j < 4; ++j) { float cs = 0.f;
#pragma unroll
                        for (int ai = 0; ai < 2; ++ai)
#pragma unroll
                            for (int m = 0; m < 4; ++m) cs += acc[ai][bj][m][n][j];
                        cs += __shfl_xor(cs, 1); cs += __shfl_xor(cs, 2); cs += __shfl_xor(cs, 4); cs += __shfl_xor(cs, 8);
                        if (fr == 0) atomicAdd(km + bj * HALF + 4 * n + j, cs); }
#pragma unroll
            for (int bj = 0; bj < 2; ++bj) { float v = mx[bj];
                v = fmaxf(v, __shfl_xor(v, 1)); v = fmaxf(v, __shfl_xor(v, 2)); v = fmaxf(v, __shfl_xor(v, 4)); v = fmaxf(v, __shfl_xor(v, 8));
                if (fr == 0 && fq == 0) atomicMax(khmax + (u.pm >> 5) * 32 + ct * 8 + bj * 4 + wc, __float_as_uint(sqrtf(v))); }
        } else if (kind == 3) {
            PG8_LAS unsigned char* stg = stage + (wr * 4 + wc) * 2304; const int lane = fq * 16 + fr;
            bf16_t* vfb = VA + ((size_t)((u.pm >> 5) * 16 + 4 * ct + (wc >> 1)) * 65536 + (size_t)(u.pm & 31) * 2048 + (2 * (wc & 1)) * 512 + (2 * wr + ((lane & 7) >> 2)) * 64 + (lane & 3) * 16 + 8 * ((lane >> 5) & 1) + ((lane >> 3) & 3)) * 8;
#pragma unroll
            for (int ai = 0; ai < 2; ++ai)
#pragma unroll
                for (int bj = 0; bj < 2; ++bj)
#pragma unroll
                    for (int n = 0; n < 2; ++n) {
#pragma unroll
                        for (int m = 0; m < 4; ++m)
#pragma unroll
                            for (int j = 0; j < 4; ++j) { const float lo = acc[ai][bj][m][n][j]; *(PG8_LAS bf16_t*)(stg + (4 * fq + j) * 144 + (16 * m + fr) * 2) = (bf16_t)(cvt_pk_bf16(lo, lo) & 0xffffu); }
                        asm volatile("s_waitcnt lgkmcnt(0)" ::: "memory");
                        const int trow = u.pm * BM + ai * HALF + wr * 64; const int bb = trow >> 13, t0 = trow & 8191;
#pragma unroll
                        for (int i = 0; i < 2; ++i) { const int id = lane + 64 * i, col = id >> 3, ch = id & 7;
                            const u32x4 v = *(const PG8_LAS u32x4*)(stg + col * 144 + ch * 16);
                            *(u32x4*)(vfb + (size_t)bj * (2 * 65536 * 8) + (ai * 256 + n * 4 + i * 512) * 8) = v; }
                        asm volatile("s_waitcnt lgkmcnt(0)" ::: "memory"); }
        } else {
#pragma unroll
            for (int ai = 0; ai < 2; ++ai)
#pragma unroll
                for (int m = 0; m < 4; ++m)
#pragma unroll
                    for (int bj = 0; bj < 2; ++bj) { float o[8];
#pragma unroll
                        for (int n = 0; n < 2; ++n)
#pragma unroll
                            for (int j = 0; j < 4; ++j) { const float v = acc[ai][bj][m][n][j]; o[4 * n + j] = kind == 1 ? v * QSCALE : kind == 4 ? sigm(v) : v; }
                        *(u32x4*)(base + (size_t)(ai * HALF + m * 16) * 1024 + bj * HALF) = pack8(o); }
        }
    }
};
template <bool BASE_BF16> struct EpiResid {
    static constexpr bool PERM = true, AFTER_DRAIN = false;
    const void* base; bf16_t* outb; float* ss; bf16_t* outb2; int row2;
    static constexpr int NB = BASE_BF16 ? 1 : 2;
    __device__ __forceinline__ void ld(u32x4 (&d)[2][NB], size_t off) const {
#pragma unroll
        for (int bj = 0; bj < 2; ++bj) {
            if (BASE_BF16) d[bj][0] = *(const u32x4*)((const bf16_t*)base + off + bj * HALF);
            else { d[bj][0] = *(const u32x4*)((const float*)base + off + bj * HALF); d[bj][NB - 1] = *(const u32x4*)((const float*)base + off + bj * HALF + 4); } }
    }
    __device__ __forceinline__ void operator()(const f32x4 (&acc)[2][2][4][2], const Unit& u, int wr, int wc, int fr, int fq) const {
        const int row0 = u.pm * BM + wr * 64 + fr, col0 = u.pn * BM + wc * 32 + 8 * fq;
        u32x4 pre[4][2][NB];
#pragma unroll
        for (int m = 0; m < 4; ++m) ld(pre[m], (size_t)(row0 + m * 16) * 1024 + col0);
#pragma unroll
        for (int ai = 0; ai < 2; ++ai)
#pragma unroll
            for (int m = 0; m < 4; ++m) { const int row = row0 + ai * HALF + m * 16; const size_t off = (size_t)row * 1024 + col0; float s = 0.f;
                u32x4 cur[2][NB];
#pragma unroll
                for (int bj = 0; bj < 2; ++bj)
#pragma unroll
                    for (int q = 0; q < NB; ++q) cur[bj][q] = pre[m][bj][q];
                if (ai == 0) ld(pre[m], off + (size_t)HALF * 1024);
#pragma unroll
                for (int bj = 0; bj < 2; ++bj) { f32x4 b0, b1;
                    if (BASE_BF16) { const u32x4 w = cur[bj][0];
                        b0 = (f32x4){__uint_as_float(w.x << 16), __uint_as_float(w.x & 0xffff0000u), __uint_as_float(w.y << 16), __uint_as_float(w.y & 0xffff0000u)};
                        b1 = (f32x4){__uint_as_float(w.z << 16), __uint_as_float(w.z & 0xffff0000u), __uint_as_float(w.w << 16), __uint_as_float(w.w & 0xffff0000u)}; }
                    else { b0 = __builtin_bit_cast(f32x4, cur[bj][0]); b1 = __builtin_bit_cast(f32x4, cur[bj][NB - 1]); }
                    const f32x4 v0 = acc[ai][bj][m][0] + b0, v1 = acc[ai][bj][m][1] + b1;
                    const float o[8] = {v0[0], v0[1], v0[2], v0[3], v1[0], v1[1], v1[2], v1[3]};
                    *(u32x4*)((row < row2 ? outb : outb2 - (size_t)row2 * 1024) + off + bj * HALF) = pack8(o);
#pragma unroll
                    for (int j = 0; j < 8; ++j) s += o[j] * o[j]; }
                s += __shfl_xor(s, 16); s += __shfl_xor(s, 32);
                if (fq == 0) atomicAdd(ss + row, s); }
    }
};
struct EpiFF1 {
    static constexpr bool PERM = true, AFTER_DRAIN = false;
    bf16_t* O; const float* ss; float eps;
    __device__ __forceinline__ void operator()(const f32x4 (&acc)[2][2][4][2], const Unit& u, int wr, int wc, int fr, int fq) const {
        const int row0 = u.pm * BM + wr * 64 + fr, col0 = u.pn * BM + wc * 32 + 8 * fq;
        float ssv[2][4];
#pragma unroll
        for (int ai = 0; ai < 2; ++ai)
#pragma unroll
            for (int m = 0; m < 4; ++m) ssv[ai][m] = ss[row0 + ai * HALF + m * 16];
#pragma unroll
        for (int ai = 0; ai < 2; ++ai)
#pragma unroll
            for (int m = 0; m < 4; ++m) { const int row = row0 + ai * HALF + m * 16; const float rs = 1.0f / sqrtf(ssv[ai][m] * (1.0f / 1024.0f) + eps);
#pragma unroll
                for (int bj = 0; bj < 2; ++bj) { float o[8];
#pragma unroll
                    for (int n = 0; n < 2; ++n)
#pragma unroll
                        for (int j = 0; j < 4; ++j) { const float v = fmaxf(acc[ai][bj][m][n][j] * rs, 0.f); o[4 * n + j] = v * v; }
                    *(u32x4*)(O + (size_t)row * 4096 + col0 + bj * HALF) = pack8(o); } }
    }
};
struct EpiStore {
    static constexpr bool PERM = true, AFTER_DRAIN = false;
    bf16_t* O;
    __device__ __forceinline__ void operator()(const f32x4 (&acc)[2][2][4][2], const Unit& u, int wr, int wc, int fr, int fq) const {
        const int row0 = u.pm * BM + wr * 64 + fr, col0 = u.pn * BM + wc * 32 + 8 * fq;
#pragma unroll
        for (int ai = 0; ai < 2; ++ai)
#pragma unroll
            for (int m = 0; m < 4; ++m)
#pragma unroll
                for (int bj = 0; bj < 2; ++bj) { float o[8];
#pragma unroll
                    for (int n = 0; n < 2; ++n)
#pragma unroll
                        for (int j = 0; j < 4; ++j) o[4 * n + j] = acc[ai][bj][m][n][j];
                    *(u32x4*)(O + (size_t)(row0 + ai * HALF + m * 16) * 1024 + col0 + bj * HALF) = pack8(o); }
    }
};
struct EpiPle {
    static constexpr bool PERM = true, AFTER_DRAIN = false;
    const bf16_t* X; const bf16_t* X2; int row2; const bf16_t* PP; const float* ssin; float* ssout; float eps; unsigned* pcnt; const float* gf; float* out;
    __device__ __forceinline__ void operator()(const f32x4 (&acc_)[2][2][4][2], const Unit& u, int wr, int wc, int fr, int fq) const {
        f32x4 (&acc)[2][2][4][2] = const_cast<f32x4 (&)[2][2][4][2]>(acc_);
        const int row0 = u.pm * BM + wr * 64 + fr, col0 = u.pn * BM + wc * 32 + 8 * fq;
        constexpr int PD = 3;
        float ssv[2][4]; u32x4 xq[PD][2], pq[PD][2];
#pragma unroll
        for (int ai = 0; ai < 2; ++ai)
#pragma unroll
            for (int m = 0; m < 4; ++m) ssv[ai][m] = ssin[row0 + ai * HALF + m * 16];
#define PLE_LD(slot, it_) do { const int rn_ = row0 + ((it_) >> 2) * HALF + ((it_) & 3) * 16; const size_t offn_ = (size_t)rn_ * 1024 + col0; \
            _Pragma("unroll") for (int bj = 0; bj < 2; ++bj) { xq[slot][bj] = *(const u32x4*)((rn_ < row2 ? X : X2 - (size_t)row2 * 1024) + offn_ + bj * HALF); pq[slot][bj] = *(const u32x4*)(PP + offn_ + bj * HALF); } } while (0)
#pragma unroll
        for (int it = 0; it < PD; ++it) PLE_LD(it, it);
#pragma unroll
        for (int it = 0; it < 8; ++it) { const int ai = it >> 2, m = it & 3; const int row = row0 + ai * HALF + m * 16; const float rs = 1.0f / sqrtf(ssv[ai][m] * (1.0f / 1024.0f) + eps); float s = 0.f;
                u32x4 xc[2], pc[2];
#pragma unroll
                for (int bj = 0; bj < 2; ++bj) { xc[bj] = xq[it % PD][bj]; pc[bj] = pq[it % PD][bj]; }
                if (it + PD < 8) PLE_LD(it % PD, it + PD);
#pragma unroll
                for (int bj = 0; bj < 2; ++bj) { const u32x4 xw = xc[bj];
                    const f32x4 b0 = {__uint_as_float(xw.x << 16), __uint_as_float(xw.x & 0xffff0000u), __uint_as_float(xw.y << 16), __uint_as_float(xw.y & 0xffff0000u)};
                    const f32x4 b1 = {__uint_as_float(xw.z << 16), __uint_as_float(xw.z & 0xffff0000u), __uint_as_float(xw.w << 16), __uint_as_float(xw.w & 0xffff0000u)};
                    const u32x4 pw = pc[bj];
                    const float pp[8] = {__uint_as_float(pw.x << 16), __uint_as_float(pw.x & 0xffff0000u), __uint_as_float(pw.y << 16), __uint_as_float(pw.y & 0xffff0000u),
                                         __uint_as_float(pw.z << 16), __uint_as_float(pw.z & 0xffff0000u), __uint_as_float(pw.w << 16), __uint_as_float(pw.w & 0xffff0000u)};
                    f32x4 v0, v1;
#pragma unroll
                    for (int j = 0; j < 4; ++j) { v0[j] = b0[j] + sigm(acc[ai][bj][m][0][j] * rs) * pp[j]; v1[j] = b1[j] + sigm(acc[ai][bj][m][1][j] * rs) * pp[4 + j]; }
                    acc[ai][bj][m][0] = v0; acc[ai][bj][m][1] = v1;
#pragma unroll
                    for (int j = 0; j < 4; ++j) s += v0[j] * v0[j] + v1[j] * v1[j]; }
                s += __shfl_xor(s, 16); s += __shfl_xor(s, 32);
                if (fq == 0) atomicAdd(ssout + row, s); }
#undef PLE_LD
        asm volatile("s_waitcnt vmcnt(0)" ::: "memory"); __syncthreads();
        if (threadIdx.x == 0) { unsigned* c = pcnt + 64 * u.pm; __hip_atomic_fetch_add(c, 1u, __ATOMIC_RELAXED, __HIP_MEMORY_SCOPE_AGENT);
            unsigned sp = 0; while (__hip_atomic_load(c, __ATOMIC_RELAXED, __HIP_MEMORY_SCOPE_AGENT) < 4u) { __builtin_amdgcn_s_sleep(1); if (++sp > (1u << 22)) break; } }
        __syncthreads();
        float so[2][4]; f32x4 gq[2][2];
#pragma unroll
        for (int ai = 0; ai < 2; ++ai)
#pragma unroll
            for (int m = 0; m < 4; ++m) so[ai][m] = __hip_atomic_load(ssout + row0 + ai * HALF + m * 16, __ATOMIC_RELAXED, __HIP_MEMORY_SCOPE_AGENT);
#pragma unroll
        for (int bj = 0; bj < 2; ++bj) { gq[bj][0] = *(const f32x4*)(gf + col0 + bj * HALF); gq[bj][1] = *(const f32x4*)(gf + col0 + bj * HALF + 4); }
#pragma unroll
        for (int ai = 0; ai < 2; ++ai)
#pragma unroll
            for (int m = 0; m < 4; ++m) { const int row = row0 + ai * HALF + m * 16; const size_t off = (size_t)row * 1024 + col0;
                const float rs = 1.0f / sqrtf(so[ai][m] * (1.0f / 1024.0f) + eps);
#pragma unroll
                for (int bj = 0; bj < 2; ++bj) { *(f32x4*)(out + off + bj * HALF) = acc[ai][bj][m][0] * rs * gq[bj][0]; *(f32x4*)(out + off + bj * HALF + 4) = acc[ai][bj][m][1] * rs * gq[bj][1]; } }
    }
};

template <class Epi, class Sched, bool ALIGN_EPI = false, bool SP2 = false>
__device__ __forceinline__ void gemm_phase(PG8_LAS unsigned char* lds, const Gemm g, const Sched& S, const Epi& E) {
    int tid_ = threadIdx.x; asm volatile("" : "+v"(tid_));
    const int tid = tid_, wid = __builtin_amdgcn_readfirstlane(tid >> 6), lane = tid & 63, wr = wid >> 2, wc = wid & 3, fr = lane & 15, fq = lane >> 4;
    const int K = g.K, nt = K / BK;
    unsigned voffA[2], voffB[2];
#pragma unroll
    for (int i = 0; i < 2; ++i) { int R, C; stage_rc(tid * 16 + i * 8192, R, C); const int Rb = Epi::PERM ? ((R & ~31) + perm32(R & 31)) : R;
        voffA[i] = (unsigned)(R * K + C) * 2u; voffB[i] = (unsigned)(Rb * K + C) * 2u; }
    const size_t kstep = (size_t)(BK * 2);
    const size_t hstep = (size_t)HALF * K * 2;
    const size_t tstep = 2 * hstep;
    const unsigned ldsw = (unsigned)wid * 1024u;
    const int aoff = lds_byte(wr * 64 + fr, fq * 8), boff = lds_byte(wc * 32 + fr, fq * 8);
#define PG8_ABASE(pm_) ((pm_) < g.pm2 ? (const char*)g.A + (size_t)(pm_) * tstep : (const char*)g.A2 + (size_t)((pm_) - g.pm2) * tstep)
#define PG8_SA(b, h) (((b) * 2 + (h)) * HTB)
#define PG8_SB(b, h) ((4 + (b) * 2 + (h)) * HTB)
#define PG8_STAGE(bufoff, gbase, voff) do { _Pragma("unroll") for (int _i = 0; _i < 2; ++_i) \
        __builtin_amdgcn_global_load_lds((const unsigned*)((const char*)(gbase) + (voff)[_i]), (PG8_LAS unsigned*)(lds + (bufoff) + ldsw + _i * 8192), 16, 0, 0); } while (0)
#define PG8_LDA(dst, b, h) do { _Pragma("unroll") for (int m = 0; m < 4; ++m) _Pragma("unroll") for (int k = 0; k < 2; ++k) dst[m][k] = *(const PG8_LAS bf16x8*)(lds + PG8_SA(b, h) + aoff + m * 2048 + k * 1024); } while (0)
#define PG8_LDB(dst, b, h) do { _Pragma("unroll") for (int n = 0; n < 2; ++n) _Pragma("unroll") for (int k = 0; k < 2; ++k) dst[n][k] = *(const PG8_LAS bf16x8*)(lds + PG8_SB(b, h) + boff + n * 2048 + k * 1024); } while (0)
#define PG8_MMA(ai, bj, At, Bt) do { __builtin_amdgcn_s_setprio(1); _Pragma("unroll") for (int m = 0; m < 4; ++m) _Pragma("unroll") for (int n = 0; n < 2; ++n) _Pragma("unroll") for (int k = 0; k < 2; ++k) \
        acc[ai][bj][m][n] = __builtin_amdgcn_mfma_f32_16x16x32_bf16(Bt[n][k], At[m][k], acc[ai][bj][m][n], 0, 0, 0); __builtin_amdgcn_s_setprio(0); } while (0)
#define PG8_WAIT_V(n) asm volatile("s_waitcnt vmcnt(" #n ")" ::: "memory")
#define PG8_WAIT_L(n) asm volatile("s_waitcnt lgkmcnt(" #n ")" ::: "memory")
#define PG8_BAR __builtin_amdgcn_s_barrier()
#define PG8_SCHED __builtin_amdgcn_sched_barrier(0)
    Unit cur, nxt; int ui = 0;
    if (!S.next(0, cur)) return;
    f32x4 acc[2][2][4][2];
#pragma unroll
    for (int a = 0; a < 2; ++a)
#pragma unroll
        for (int b = 0; b < 2; ++b)
#pragma unroll
            for (int m = 0; m < 4; ++m)
#pragma unroll
                for (int n = 0; n < 2; ++n) acc[a][b][m][n] = (f32x4){0.f, 0.f, 0.f, 0.f};
    bf16x8 At[4][2], B0[2][2], B1[2][2];
    const char* cA = PG8_ABASE(cur.pm); const char* cB = (const char*)g.Bt + (size_t)cur.pn * tstep;
    S.a_ready(cur);
    if constexpr (SP2) {
        PG8_STAGE(PG8_SB(0, 0), cB, voffB); PG8_STAGE(PG8_SB(0, 1), cB + hstep, voffB); PG8_STAGE(PG8_SA(0, 0), cA, voffA); PG8_STAGE(PG8_SA(0, 1), cA + hstep, voffA);
        if (wr == 1) PG8_BAR;
        PG8_WAIT_V(2); PG8_BAR;
        PG8_STAGE(PG8_SB(1, 0), cB + kstep, voffB); PG8_STAGE(PG8_SA(1, 0), cA + kstep, voffA); PG8_STAGE(PG8_SB(1, 1), cB + hstep + kstep, voffB);
        PG8_WAIT_V(6); PG8_BAR;
    } else {
        PG8_STAGE(PG8_SB(0, 0), cB, voffB); PG8_STAGE(PG8_SA(0, 0), cA, voffA); PG8_STAGE(PG8_SB(0, 1), cB + hstep, voffB); PG8_STAGE(PG8_SA(0, 1), cA + hstep, voffA);
        if (wr == 1) PG8_BAR;
        PG8_WAIT_V(4); PG8_BAR;
        PG8_STAGE(PG8_SB(1, 0), cB + kstep, voffB); PG8_STAGE(PG8_SA(1, 0), cA + kstep, voffA); PG8_STAGE(PG8_SB(1, 1), cB + hstep + kstep, voffB);
        PG8_WAIT_V(6); PG8_BAR;
    }
    for (;;) {
        const bool has_next = S.next(ui + 1, nxt);
        const char* nA = has_next ? PG8_ABASE(nxt.pm) : cA; const char* nB = has_next ? (const char*)g.Bt + (size_t)nxt.pn * tstep : cB;
        for (int t = 0; t < nt; t += 2) {
            const bool last = (t == nt - 2);
            const char* a1 = cA + (size_t)(t + 1) * kstep;
            const char* a2 = last ? nA : cA + (size_t)(t + 2) * kstep; const char* b2 = last ? nB : cB + (size_t)(t + 2) * kstep;
            const char* a3 = a2 + kstep; const char* b3 = b2 + kstep;
            if (last && has_next) S.a_ready(nxt);
            if constexpr (SP2) {
            PG8_LDB(B0, 0, 0); PG8_LDB(B1, 0, 1); PG8_SCHED; PG8_LDA(At, 0, 0); PG8_STAGE(PG8_SA(1, 1), a1 + hstep, voffA);
            PG8_WAIT_V(8); PG8_WAIT_L(0); PG8_BAR; PG8_MMA(0, 0, At, B0); PG8_MMA(0, 1, At, B1); PG8_BAR; PG8_SCHED;
            PG8_LDA(At, 0, 1); PG8_STAGE(PG8_SB(0, 0), b2, voffB); PG8_STAGE(PG8_SB(0, 1), b2 + hstep, voffB); PG8_STAGE(PG8_SA(0, 0), a2, voffA);
            PG8_WAIT_V(8); PG8_WAIT_L(0); PG8_BAR; PG8_MMA(1, 0, At, B0); PG8_MMA(1, 1, At, B1); PG8_BAR; PG8_SCHED;
            PG8_LDB(B0, 1, 0); PG8_LDB(B1, 1, 1); PG8_SCHED; PG8_LDA(At, 1, 0); PG8_STAGE(PG8_SA(0, 1), a2 + hstep, voffA);
            PG8_WAIT_V(8); PG8_WAIT_L(0); PG8_BAR; PG8_MMA(0, 0, At, B0); PG8_MMA(0, 1, At, B1); PG8_BAR; PG8_SCHED;
            PG8_LDA(At, 1, 1); PG8_STAGE(PG8_SB(1, 0), b3, voffB); PG8_STAGE(PG8_SB(1, 1), b3 + hstep, voffB); PG8_STAGE(PG8_SA(1, 0), a3, voffA);
            PG8_WAIT_V(8); PG8_WAIT_L(0); PG8_BAR; PG8_MMA(1, 0, At, B0); PG8_MMA(1, 1, At, B1); PG8_BAR; PG8_SCHED;
            } else {
            PG8_LDB(B0, 0, 0); PG8_SCHED; PG8_LDA(At, 0, 0); PG8_STAGE(PG8_SA(1, 1), a1 + hstep, voffA);
            PG8_WAIT_L(8); PG8_BAR; PG8_WAIT_L(0); PG8_MMA(0, 0, At, B0); PG8_BAR; PG8_SCHED;
            PG8_LDB(B1, 0, 1); PG8_STAGE(PG8_SB(0, 0), b2, voffB);
            PG8_BAR; PG8_WAIT_L(0); PG8_MMA(0, 1, At, B1); PG8_BAR;
            PG8_LDA(At, 0, 1); PG8_STAGE(PG8_SA(0, 0), a2, voffA);
            PG8_BAR; PG8_WAIT_L(0); PG8_MMA(1, 0, At, B0); PG8_BAR; PG8_SCHED;
            PG8_STAGE(PG8_SB(0, 1), b2 + hstep, voffB);
            PG8_WAIT_V(6); PG8_BAR; PG8_MMA(1, 1, At, B1); PG8_BAR;
            PG8_LDB(B0, 1, 0); PG8_SCHED; PG8_LDA(At, 1, 0); PG8_STAGE(PG8_SA(0, 1), a2 + hstep, voffA);
            PG8_WAIT_L(8); PG8_BAR; PG8_WAIT_L(0); PG8_MMA(0, 0, At, B0); PG8_BAR; PG8_SCHED;
            PG8_LDB(B1, 1, 1); PG8_STAGE(PG8_SB(1, 0), b3, voffB);
            PG8_BAR; PG8_WAIT_L(0); PG8_MMA(0, 1, At, B1); PG8_BAR;
            PG8_LDA(At, 1, 1); PG8_STAGE(PG8_SA(1, 0), a3, voffA);
            PG8_BAR; PG8_WAIT_L(0); PG8_MMA(1, 0, At, B0); PG8_BAR; PG8_SCHED;
            PG8_STAGE(PG8_SB(1, 1), b3 + hstep, voffB);
            PG8_WAIT_V(6); PG8_BAR; PG8_MMA(1, 1, At, B1); PG8_BAR;
            }
        }
        if constexpr (ALIGN_EPI) { if (wr == 0) PG8_BAR; }
        if constexpr (!Epi::AFTER_DRAIN) { E(acc, cur, wr, wc, fr, fq); S.done(cur); }
        if (!has_next) break;
#pragma unroll
        for (int a = 0; a < 2; ++a)
#pragma unroll
            for (int b = 0; b < 2; ++b)
#pragma unroll
                for (int m = 0; m < 4; ++m)
#pragma unroll
                    for (int n = 0; n < 2; ++n) acc[a][b][m][n] = (f32x4){0.f, 0.f, 0.f, 0.f};
        cur = nxt; cA = nA; cB = nB; ++ui;
        if constexpr (ALIGN_EPI) { if (wr == 1) PG8_BAR; }
    }
    PG8_WAIT_V(0);
    if constexpr (!ALIGN_EPI) { if (wr == 0) PG8_BAR; }
    PG8_BAR;
    if constexpr (Epi::AFTER_DRAIN) { E.fused(acc, cur, wr, wc, fr, fq, lds, wid, lane); S.done(cur); }
#undef PG8_ABASE
#undef PG8_SA
#undef PG8_SB
#undef PG8_STAGE
#undef PG8_LDA
#undef PG8_LDB
#undef PG8_MMA
#undef PG8_WAIT_V
#undef PG8_WAIT_L
#undef PG8_BAR
#undef PG8_SCHED
}
}
#define GAS __attribute__((address_space(1)))
#define LAS __attribute__((address_space(3)))
typedef unsigned short bf16;
typedef unsigned v4u __attribute__((ext_vector_type(4)));
typedef float f32x4 __attribute__((ext_vector_type(4)));
typedef short bf16x8 __attribute__((ext_vector_type(8)));
typedef GAS unsigned gu32;
typedef GAS unsigned long long gu64;
#define RLX_AGENT __ATOMIC_RELAXED, __HIP_MEMORY_SCOPE_AGENT
#define LDS_WAIT() asm volatile("s_waitcnt lgkmcnt(0)" ::: "memory")
#define VM_WAIT() asm volatile("s_waitcnt vmcnt(0)" ::: "memory")
__device__ __forceinline__ unsigned long long rt() { return __builtin_amdgcn_s_memrealtime(); }
__device__ __forceinline__ unsigned f2bf(float f) { unsigned u = __builtin_bit_cast(unsigned, f); return (u + 0x7fffu + ((u >> 16) & 1u)) >> 16; }
__device__ __forceinline__ unsigned pk2(float lo, float hi) { return f2bf(lo) | (f2bf(hi) << 16); }

#define XB_TMO      128
#define XB_XCNT(j)  (256  + 64 * (j))
#define XB_XSUB(j)  (1280 + 64 * (j))
#define XB_XGEN(j)  (2304 + 64 * (j))
#define XB_TOP      3328
#define XB_TOPGEN   3392
#define XCD_BAR_WORDS 3456
#define XB_GSUB(j)  (3520 + 64 * (j))
#define XB_GGEN(j)  (4096 + 64 * (j))
#define XB_XID      4672
#define XB_SPIN_CAP (1u << 22)

__device__ __forceinline__ unsigned xb_ld(unsigned* p)              { return __hip_atomic_load(p, __ATOMIC_RELAXED, __HIP_MEMORY_SCOPE_AGENT); }
__device__ __forceinline__ unsigned xb_add(unsigned* p, unsigned v) { return __hip_atomic_fetch_add(p, v, __ATOMIC_RELAXED, __HIP_MEMORY_SCOPE_AGENT); }
__device__ __forceinline__ unsigned xb_xcc_id() { return (unsigned)__builtin_amdgcn_s_getreg((3 << 11) | 20) & 0xFu; }
#define XB_SPIN(cond, bar) do { unsigned _sp = 0; while (cond) { __builtin_amdgcn_s_sleep(1); \
    if ((++_sp & 255u) == 0u) { if (xb_ld(&(bar)[XB_TMO])) break; if (_sp > XB_SPIN_CAP) { atomicAdd(&(bar)[XB_TMO], 1u); break; } } } } while (0)

struct XcdBarrier {
    unsigned* bar; unsigned x;
    volatile LAS unsigned* st;
};

__device__ __forceinline__ XcdBarrier xcd_barrier_post(unsigned* bar, volatile LAS unsigned* st) {
    XcdBarrier b; b.bar = bar; b.x = xb_xcc_id(); b.st = st;
    if (threadIdx.x == 0) { (void)xb_add(&bar[XB_XCNT(b.x)], 1u); if (blockIdx.x < 256) __hip_atomic_store(&bar[XB_XID + blockIdx.x], b.x + 1u, __ATOMIC_RELAXED, __HIP_MEMORY_SCOPE_AGENT); }
    return b;
}
__device__ __forceinline__ void xcd_barrier_complete(unsigned* bar, unsigned x, unsigned& nloc, unsigned& nx) {
    const unsigned G = gridDim.x * gridDim.y * gridDim.z;
    unsigned sum, cnt, mine, sp = 0u;
    for (;;) {
        sum = 0u; cnt = 0u; mine = 0u;
#pragma unroll
        for (unsigned j = 0; j < 16; ++j) { const unsigned c = xb_ld(&bar[XB_XCNT(j)]); sum += c; cnt += (c > 0u) ? 1u : 0u; mine = (j == x) ? c : mine; }
        if (sum == G) break;
        __builtin_amdgcn_s_sleep(1);
        if ((++sp & 255u) == 0u) { if (xb_ld(&bar[XB_TMO])) break; if (sp > XB_SPIN_CAP) { atomicAdd(&bar[XB_TMO], 1u); break; } }
    }
    nloc = mine > 0u ? mine : 1u; nx = cnt > 0u ? cnt : 1u;
}

__device__ __forceinline__ void xcd_barrier(const XcdBarrier& b) {
    asm volatile("s_waitcnt vmcnt(0)" ::: "memory");
    __syncthreads();
    if (threadIdx.x == 0) {
        unsigned* bar = b.bar;
        __builtin_amdgcn_s_waitcnt(0);
        unsigned nloc = b.st[0], nx = b.st[1];
        if (nloc == 0u) { xcd_barrier_complete(bar, b.x, nloc, nx); b.st[0] = nloc; b.st[1] = nx; }
        const unsigned old = xb_add(&bar[XB_XSUB(b.x)], 1u);
        const unsigned gen = old / nloc;
        if (old + 1u == (gen + 1u) * nloc) {
            __builtin_amdgcn_fence(__ATOMIC_RELEASE, "agent");
            asm volatile("s_waitcnt vmcnt(0)" ::: "memory");
            const unsigned og = xb_add(&bar[XB_TOP], 1u);
            const unsigned tg = og / nx;
            if (og + 1u == (tg + 1u) * nx) xb_add(&bar[XB_TOPGEN], 1u);
            else XB_SPIN(xb_ld(&bar[XB_TOPGEN]) == tg, bar);
            __builtin_amdgcn_fence(__ATOMIC_ACQUIRE, "agent");
            xb_add(&bar[XB_XGEN(b.x)], 1u);
            asm volatile("s_waitcnt vmcnt(0)" ::: "memory");
        } else {
            XB_SPIN(xb_ld(&bar[XB_XGEN(b.x)]) == gen, bar);
            __builtin_amdgcn_fence(__ATOMIC_ACQUIRE, "agent");
            asm volatile("s_waitcnt vmcnt(0)" ::: "memory");
        }
    }
    __syncthreads();
}

__device__ __forceinline__ bool grp_local_ok(const XcdBarrier& b, volatile LAS unsigned* flag) {
    if (threadIdx.x == 0) *flag = 1u;
    __syncthreads();
    if (gridDim.x != 256) { if (threadIdx.x == 0) *flag = 0u; }
    else if (threadIdx.x < 256) { const unsigned mine = xb_ld(&b.bar[XB_XID + threadIdx.x]), first = xb_ld(&b.bar[XB_XID + (threadIdx.x & 7)]); if (mine != first || mine == 0u) *flag = 0u; }
    __syncthreads();
    return *flag != 0u;
}
__device__ __forceinline__ void grp_barrier(const XcdBarrier& b, unsigned g) {
    asm volatile("s_waitcnt vmcnt(0)" ::: "memory");
    __syncthreads();
    if (threadIdx.x == 0) {
        unsigned* bar = b.bar;
        const unsigned old = xb_add(&bar[XB_GSUB(g)], 1u), gen = old / 32u;
        if (old + 1u == (gen + 1u) * 32u) xb_add(&bar[XB_GGEN(g)], 1u);
        else XB_SPIN(xb_ld(&bar[XB_GGEN(g)]) == gen, bar);
        __builtin_amdgcn_fence(__ATOMIC_ACQUIRE, "agent");
        asm volatile("s_waitcnt vmcnt(0)" ::: "memory");
    }
    __syncthreads();
}

constexpr int NWAVES = 8;
constexpr int BATCH = 2, SEQ = 8192, D = 1024, H = 16, HD = 64, FF = 4096, PLE = 256, NIN = 7168;
constexpr int M = BATCH * SEQ;
constexpr float EPS = 1e-6f;
constexpr float LOG2E = 1.4426950408889634f;

constexpr size_t MiB = 1u << 20, KiB = 1u << 10;
constexpr size_t WS_CTL = 0, CTL_ZERO_BYTES = 1 * MiB;
constexpr size_t CT_STATS1 = 0;
constexpr size_t CT_SS2 = 128 * KiB, CT_SS3 = 192 * KiB, CT_SS4 = 256 * KiB;
constexpr size_t CT_KMEAN = 320 * KiB;
constexpr size_t CT_KHMAX = 576 * KiB;
constexpr size_t CT_PCNT = 600 * KiB;
constexpr size_t CT_BAR = 640 * KiB;
constexpr size_t WS_WIN = 1 * MiB, WS_WOUT = 15 * MiB, WS_W1 = 17 * MiB, WS_W2 = 25 * MiB, WS_WG = 33 * MiB, WS_WP = 35 * MiB;
constexpr size_t WS_WM = 35 * MiB + 512 * KiB, WS_LUT = 35 * MiB + 768 * KiB;
constexpr size_t WS_Q = 36 * MiB, WS_K = 68 * MiB, WS_UG = 100 * MiB, WS_VS = 132 * MiB, WS_VA = 164 * MiB, WS_GB = 196 * MiB, WS_PB = 228 * MiB;
constexpr size_t WS_X1 = 36 * MiB;
constexpr size_t WS_A = 100 * MiB;
constexpr size_t WS_X2B_LO = 36 * MiB, WS_X2B_HI = 52 * MiB;
constexpr size_t WS_END = 256 * MiB;

constexpr int RING_OFF = 0, RING_BYTES = 131072;
constexpr int LDSCTL_OFF = 156816, MISC_OFF = LDSCTL_OFF + 320;
constexpr int LDS_BYTES = 159744;

struct Frame {
    LAS unsigned char* lds;
    volatile LAS unsigned* MISC;
    unsigned char* ws;
    int tid, lane, wave, vcu, G;
    const float* in[17];
    float* out;
};

__device__ __forceinline__ float wave_sum(float v) {
#pragma unroll
    for (int o = 1; o < 64; o <<= 1) v += __shfl_xor(v, o);
    return v;
}
__device__ __forceinline__ float wave_max(float v) {
#pragma unroll
    for (int o = 1; o < 64; o <<= 1) v = fmaxf(v, __shfl_xor(v, o));
    return v;
}
__device__ __forceinline__ int wave_min_i(int v) {
#pragma unroll
    for (int o = 1; o < 64; o <<= 1) { const int t = __shfl_xor(v, o); v = t < v ? t : v; }
    return v;
}
__device__ __forceinline__ float bflo(unsigned w) { return __uint_as_float(w << 16); }
__device__ __forceinline__ float bfhi(unsigned w) { return __uint_as_float(w & 0xffff0000u); }

__device__ __forceinline__ int win_rowmap(int c) {
    if (c < 1024) return (c >> 7) * 256 + (c & 127);
    if (c < 5120) return c + 1024;
    if (c < 6144) { const int d = c - 5120; return (d >> 7) * 256 + 128 + (d & 127); }
    return c;
}
__device__ __forceinline__ void p0_transpose_item(const float* W, int K, int N, bf16* WT, int dst_row0, int k0, int n0, const float* gk, LAS float* scr, int lane) {
#pragma unroll 8
    for (int i = 0; i < 32; ++i) { const int kk = 2 * i + (lane >> 5); scr[kk * 33 + (lane & 31)] = W[(size_t)(k0 + kk) * N + n0 + (lane & 31)]; }
    LDS_WAIT(); asm volatile("" ::: "memory");
    const int c = lane & 7;
    float g[8];
#pragma unroll
    for (int e = 0; e < 8; ++e) g[e] = gk ? gk[k0 + 8 * c + e] : 1.0f;
#pragma unroll
    for (int j = 0; j < 4; ++j) { const int n = (lane >> 3) + 8 * j; const LAS float* s = scr + (8 * c) * 33 + n;
        v4u o; o.x = pk2(s[0 * 33] * g[0], s[1 * 33] * g[1]); o.y = pk2(s[2 * 33] * g[2], s[3 * 33] * g[3]); o.z = pk2(s[4 * 33] * g[4], s[5 * 33] * g[5]); o.w = pk2(s[6 * 33] * g[6], s[7 * 33] * g[7]);
        *(GAS v4u*)(WT + (size_t)(dst_row0 + n) * K + k0 + 8 * c) = o; }
    LDS_WAIT(); asm volatile("" ::: "memory");
}
__device__ __forceinline__ int rel_bucket(int n) {
    if (n < 16) return n;
    int b = 16;
    b += (n >= 21); b += (n >= 27); b += (n >= 35); b += (n >= 46); b += (n >= 59); b += (n >= 77); b += (n >= 99); b += (n >= 128);
    b += (n >= 166); b += (n >= 216); b += (n >= 280); b += (n >= 363); b += (n >= 470); b += (n >= 609); b += (n >= 790);
    return b;
}
__device__ __forceinline__ void p0_prologue(Frame& F, const int part) {
    LAS float* scr = (LAS float*)(F.lds + RING_OFF + F.wave * 16384);
    const int gw = F.vcu * NWAVES + F.wave, NGW = F.G * NWAVES;
    const float *x = F.in[0], *p = F.in[1], *g_mix = F.in[2], *w_in = F.in[3], *w_s = F.in[4], *rel = F.in[8], *w_out = F.in[9], *g_ffn = F.in[10], *w1 = F.in[11], *w2 = F.in[12], *g_ple = F.in[13], *wg = F.in[14], *wp = F.in[15];
    bf16 *Win_t = (bf16*)(F.ws + WS_WIN), *Wout_t = (bf16*)(F.ws + WS_WOUT), *W1_t = (bf16*)(F.ws + WS_W1), *W2_t = (bf16*)(F.ws + WS_W2), *Wg_t = (bf16*)(F.ws + WS_WG), *Wp_t = (bf16*)(F.ws + WS_WP);
    constexpr int I_IN = (D / 64) * (NIN / 32), I_OUT = (D / 64) * (D / 32), I_1 = (D / 64) * (FF / 32), I_2 = (FF / 64) * (D / 32), I_G = I_OUT, I_P = (PLE / 64) * (D / 32);
    constexpr int NITEMS = I_IN + I_OUT + I_1 + I_2 + I_G + I_P;
    for (int it = (part == 0 ? gw : I_IN + gw); it < (part == 0 ? I_IN : NITEMS); it += NGW) {
        int r = it;
        if (r < I_IN) { const int nb = r % (NIN / 32), kb = r / (NIN / 32); p0_transpose_item(w_in, D, NIN, Win_t, win_rowmap(32 * nb), 64 * kb, 32 * nb, nullptr, scr, F.lane); continue; } r -= I_IN;
        if (r < I_OUT) { const int nb = r % (D / 32), kb = r / (D / 32); p0_transpose_item(w_out, D, D, Wout_t, 32 * nb, 64 * kb, 32 * nb, nullptr, scr, F.lane); continue; } r -= I_OUT;
        if (r < I_1) { const int nb = r % (FF / 32), kb = r / (FF / 32); p0_transpose_item(w1, D, FF, W1_t, 32 * nb, 64 * kb, 32 * nb, g_ffn, scr, F.lane); continue; } r -= I_1;
        if (r < I_2) { const int nb = r % (D / 32), kb = r / (D / 32); p0_transpose_item(w2, FF, D, W2_t, 32 * nb, 64 * kb, 32 * nb, nullptr, scr, F.lane); continue; } r -= I_2;
        if (r < I_G) { const int nb = r % (D / 32), kb = r / (D / 32); p0_transpose_item(wg, D, D, Wg_t, 32 * nb, 64 * kb, 32 * nb, g_ple, scr, F.lane); continue; } r -= I_G;
        { const int nb = r % (D / 32), kb = r / (D / 32); p0_transpose_item(wp, PLE, D, Wp_t, 32 * nb, 64 * kb, 32 * nb, nullptr, scr, F.lane); }
    }
    const int gt = F.vcu * (NWAVES * 64) + F.tid, NGT = F.G * NWAVES * 64;
    if (part == 0) { bf16* Wm = (bf16*)(F.ws + WS_WM);
      for (int i = gt; i < 8 * 128 * 128; i += NGT) { const int s = i & 127, t = (i >> 7) & 127, g = i >> 14;
        Wm[((((g * 4 + (t >> 5)) * 8 + (s >> 4)) * 64 + ((s >> 3) & 1) * 32 + (t & 31)) << 3) + (s & 7)] = (bf16)f2bf(s <= t ? w_s[i] : 0.f); } }
    if (part == 0) { float* lut = (float*)(F.ws + WS_LUT);
      for (int i = gt; i < 16 * 1024; i += NGT) { const int h = i >> 10, dist = i & 1023; lut[i] = rel[rel_bucket(dist) * 16 + h] * LOG2E; }
      if (gt < 16) { float mb = -INFINITY; for (int k = 0; k < 32; ++k) mb = fmaxf(mb, rel[k * 16 + gt]); lut[16 * 1024 + gt] = mb * LOG2E; } }
    if (part == 1) { bf16* Pb = (bf16*)(F.ws + WS_PB);
      for (int i = gt; i < M * PLE / 8; i += NGT) { const f32x4 a = ((const f32x4*)p)[2 * i], b = ((const f32x4*)p)[2 * i + 1];
        v4u o; o.x = pk2(a.x, a.y); o.y = pk2(a.z, a.w); o.z = pk2(b.x, b.y); o.w = pk2(b.z, b.w); ((v4u*)Pb)[i] = o; } }
    if (part == 0) { bf16* Hn = (bf16*)F.out;
      f32x4 gv[4];
#pragma unroll
      for (int j = 0; j < 4; ++j) gv[j] = ((const f32x4*)g_mix)[F.lane + 64 * j];
      for (int m = gw; m < M; m += NGW) { const f32x4* xr = (const f32x4*)(x + (size_t)m * D) + F.lane; f32x4 v[4]; float s = 0.f;
#pragma unroll
        for (int j = 0; j < 4; ++j) { v[j] = xr[64 * j]; s += (v[j].x * v[j].x + v[j].y * v[j].y) + (v[j].z * v[j].z + v[j].w * v[j].w); }
        const float rs = 1.0f / sqrtf(wave_sum(s) * (1.0f / D) + EPS);
        unsigned long long* o8 = (unsigned long long*)(Hn + (size_t)m * D) + F.lane;
#pragma unroll
        for (int j = 0; j < 4; ++j) o8[64 * j] = (unsigned long long)pk2(v[j].x * rs * gv[j].x, v[j].y * rs * gv[j].y) | ((unsigned long long)pk2(v[j].z * rs * gv[j].z, v[j].w * rs * gv[j].w) << 32); } }
}

__device__ __forceinline__ void attn_simple(Frame& F) {
    LAS float* pbuf = (LAS float*)(F.lds + RING_OFF) + F.wave * 1024;
    const int gw = F.vcu * NWAVES + F.wave, NGW = F.G * NWAVES, lane = F.lane;
    const bf16 *Q = (const bf16*)(F.ws + WS_Q), *K = (const bf16*)(F.ws + WS_K), *VA = (const bf16*)(F.ws + WS_VA);
    const float *kmean = (const float*)(F.ws + WS_CTL + CT_KMEAN), *lut = (const float*)(F.ws + WS_LUT);
    bf16* YB = (bf16*)((unsigned char*)F.out + 32 * MiB);
    for (int item = gw; item < BATCH * H * SEQ; item += NGW) {
        const int t = item & (SEQ - 1), bh = item >> 13, b = bh >> 4, h = bh & 15, own = t >> 8;
        const size_t rowq = (size_t)b * SEQ + t;
        float q[64];
        { const v4u* qp = (const v4u*)(Q + rowq * D + h * HD);
#pragma unroll
          for (int i = 0; i < 8; ++i) { const v4u w = qp[i]; q[8 * i] = bflo(w.x); q[8 * i + 1] = bfhi(w.x); q[8 * i + 2] = bflo(w.y); q[8 * i + 3] = bfhi(w.y); q[8 * i + 4] = bflo(w.z); q[8 * i + 5] = bfhi(w.z); q[8 * i + 6] = bflo(w.w); q[8 * i + 7] = bfhi(w.w); } }
        float g = -INFINITY;
        if (lane < own) { const f32x4* km = (const f32x4*)(kmean + (size_t)(b * 32 + lane) * D + h * HD); float a = 0.f;
#pragma unroll
            for (int i = 0; i < 16; ++i) { const f32x4 kv = km[i]; a += q[4 * i] * kv.x + q[4 * i + 1] * kv.y + q[4 * i + 2] * kv.z + q[4 * i + 3] * kv.w; }
            g = a; }
        int sel[3];
#pragma unroll
        for (int r = 0; r < 3; ++r) { const float mg = wave_max(g); int idx = (g == mg && mg > -INFINITY) ? lane : 64; idx = wave_min_i(idx); sel[r] = idx; if (lane == idx) g = -INFINITY; }
        float sv[4][4]; float mx = -INFINITY;
#pragma unroll
        for (int blk = 0; blk < 4; ++blk) { const int n = blk < 3 ? sel[blk] : own;
#pragma unroll
            for (int kg = 0; kg < 4; ++kg) { float s = -INFINITY;
                if (n < 64) { const int kpos = n * 256 + kg * 64 + lane; const v4u* kp = (const v4u*)(K + ((size_t)b * SEQ + kpos) * D + h * HD); float a = 0.f;
#pragma unroll
                    for (int i = 0; i < 8; ++i) { const v4u w = kp[i]; a += q[8 * i] * bflo(w.x) + q[8 * i + 1] * bfhi(w.x) + q[8 * i + 2] * bflo(w.y) + q[8 * i + 3] * bfhi(w.y) + q[8 * i + 4] * bflo(w.z) + q[8 * i + 5] * bfhi(w.z) + q[8 * i + 6] * bflo(w.w) + q[8 * i + 7] * bfhi(w.w); }
                    const int dist = t - kpos; if (dist >= 0) s = a + lut[h * 1024 + (dist < 1023 ? dist : 1023)]; }
                sv[blk][kg] = s; mx = fmaxf(mx, s); } }
        mx = wave_max(mx);
        float l = 0.f;
#pragma unroll
        for (int blk = 0; blk < 4; ++blk)
#pragma unroll
            for (int kg = 0; kg < 4; ++kg) { const float pe = __builtin_amdgcn_exp2f(sv[blk][kg] - mx); l += pe; pbuf[blk * 256 + kg * 64 + lane] = pe; }
        l = wave_sum(l);
        LDS_WAIT(); asm volatile("" ::: "memory");
        float o = 0.f;
#pragma unroll
        for (int blk = 0; blk < 4; ++blk) { const int n = blk < 3 ? sel[blk] : own;
            if (n < 64) { const bf16* vp = VA + ((size_t)b * SEQ + n * 256) * D + h * HD + lane;
#pragma unroll 8
                for (int key = 0; key < 256; ++key) o += pbuf[blk * 256 + key] * __uint_as_float((unsigned)vp[(size_t)key * D] << 16); } }
        YB[rowq * D + h * HD + lane] = (bf16)f2bf(o / l);
        LDS_WAIT(); asm volatile("" ::: "memory");
    }
}
__device__ __forceinline__ void sgu_simple(Frame& F) {
    LAS float* vn = (LAS float*)(F.lds + RING_OFF);
    const bf16 *UG = (const bf16*)(F.ws + WS_UG), *VS = (const bf16*)(F.ws + WS_VS), *GB = (const bf16*)(F.ws + WS_GB), *YB = (const bf16*)((unsigned char*)F.out + 32 * MiB);
    bf16* MG = (bf16*)F.out;
    const float *stats = (const float*)(F.ws + WS_CTL + CT_STATS1), *w_s = F.in[4], *b_s = F.in[5], *lng = F.in[6], *lnb = F.in[7];
    const int ch = F.tid & 255, th = __builtin_amdgcn_readfirstlane(F.tid >> 8);
    for (int item = F.vcu; item < (M / 128) * 4; item += F.G) {
        const int c = item >> 2, qd = item & 3, col = 256 * qd + ch;
        __syncthreads();
        { const float lg = lng[col], lb = lnb[col];
          for (int s = th; s < 128; s += 2) { const size_t row = (size_t)c * 128 + s; const float s1 = stats[2 * row], s2 = stats[2 * row + 1];
            const float mu = s1 * (1.0f / 1024.0f), var = fmaxf(s2 * (1.0f / 1024.0f) - mu * mu, 0.f), rs = 1.0f / sqrtf(var + EPS);
            vn[s * 256 + ch] = (__uint_as_float((unsigned)VS[row * D + col] << 16) - mu) * rs * lg + lb; } }
        __syncthreads();
        const int g = __builtin_amdgcn_readfirstlane(col >> 7);
        for (int tt = 0; tt < 64; ++tt) { const int t = 64 * th + tt; const float* wr_ = w_s + ((size_t)g * 128 + t) * 128; float a = 0.f;
            for (int s = 0; s <= t; ++s) a += wr_[s] * vn[s * 256 + ch];
            const float mixed = a + b_s[g * 128 + t];
            const size_t off = ((size_t)c * 128 + t) * D + col;
            const float ug = __uint_as_float((unsigned)UG[off] << 16), gb = __uint_as_float((unsigned)GB[off] << 16), yb = __uint_as_float((unsigned)YB[off] << 16);
            MG[off] = (bf16)f2bf(ug * mixed + gb * yb); }
    }
    __syncthreads();
}

typedef short v4i16_t __attribute__((ext_vector_type(4)));
typedef unsigned u32x4_t __attribute__((ext_vector_type(4)));
typedef float f32x16 __attribute__((ext_vector_type(16)));
typedef LAS const unsigned char* lds_cptr;
__device__ __forceinline__ v4i16_t vtr(lds_cptr p) { return __builtin_amdgcn_ds_read_tr16_b64_v4i16((LAS v4i16_t*)p); }
__device__ __forceinline__ bf16x8 cat8(v4i16_t a, v4i16_t b) { return (bf16x8){a[0], a[1], a[2], a[3], b[0], b[1], b[2], b[3]}; }
__device__ __forceinline__ unsigned cvtpk(float lo, float hi) { unsigned r; asm("v_cvt_pk_bf16_f32 %0, %1, %2" : "=v"(r) : "v"(lo), "v"(hi)); return r; }
__device__ __forceinline__ int crow(int r, int hi) { return (r & 3) + 8 * (r >> 2) + 4 * hi; }
__device__ __forceinline__ bool p2_item(int vcu, int i, int& bh, int& qb) { if (i >= 4) return false; const int s = vcu & 7; bh = vcu >> 3;
    const unsigned w = s == 0 ? 0x0406161bu : s == 1 ? 0x0112131au : s == 2 ? 0x080b0c1du : s == 3 ? 0x0209171fu : s == 4 ? 0x030d111cu : s == 5 ? 0x050f1015u : s == 6 ? 0x00141819u : 0x070a0e1eu;
    qb = (int)((w >> (8 * i)) & 0xffu); return true; }

template <bool YB_GLOBAL>
__device__ __forceinline__ void sgu_item(Frame& F, int b, int h, int qb, LAS unsigned char* stage, const LAS float* Ost, const LAS float* Lst) {
    const bf16 *UG = (const bf16*)(F.ws + WS_UG), *VS = (const bf16*)(F.ws + WS_VS), *GB = (const bf16*)(F.ws + WS_GB), *YB = (const bf16*)((unsigned char*)F.out + 32 * MiB), *Wm = (const bf16*)(F.ws + WS_WM);
    bf16* MG = (bf16*)F.out;
    const float *stats = (const float*)(F.ws + WS_CTL + CT_STATS1), *b_s = F.in[5], *lng = F.in[6], *lnb = F.in[7];
    int tid_ = threadIdx.x; asm volatile("" : "+v"(tid_));
    const int lane = tid_ & 63, r32 = lane & 31, hi = lane >> 5, w = F.wave;
    const size_t row_base = (size_t)b * SEQ + 256 * qb;
    const int cc = w >> 2, tc = w & 3, g = h >> 1;
    v4u wv[4]; float s1[4], s2[4]; unsigned long long stq[4];
#pragma unroll
    for (int i = 0; i < 4; ++i) { const float* sp_ = stats + 2 * (row_base + ((F.tid + 512 * i) >> 3)); asm volatile("global_load_dwordx2 %0, %1, off" : "=v"(stq[i]) : "v"(sp_)); }
#pragma unroll
    for (int i = 0; i < 4; ++i) { const int id = F.tid + 512 * i, srow = id >> 3, pc = id & 7; const size_t row = row_base + srow;
        wv[i] = *(const v4u*)(VS + row * D + 64 * h + 8 * pc); }
    const int pc0 = F.tid & 7;
    const f32x4 g0 = *(const f32x4*)(lng + 64 * h + 8 * pc0), g1 = *(const f32x4*)(lng + 64 * h + 8 * pc0 + 4), c0 = *(const f32x4*)(lnb + 64 * h + 8 * pc0), c1 = *(const f32x4*)(lnb + 64 * h + 8 * pc0 + 4);
    const bf16* wrow = Wm + (size_t)(g * 4 + tc) * 4096 + lane * 8;
    bf16x8 wf[8];
#pragma unroll
    for (int st = 0; st < 8; ++st) wf[st] = *(const bf16x8*)(wrow + 512 * (st < 2 * (tc + 1) ? st : 0));
    const float bs = b_s[g * 128 + 32 * tc + r32];
    asm volatile("s_waitcnt vmcnt(0)" : "+v"(stq[0]), "+v"(stq[1]), "+v"(stq[2]), "+v"(stq[3]) :: "memory");
#pragma unroll
    for (int i = 0; i < 4; ++i) { s1[i] = __uint_as_float((unsigned)stq[i]); s2[i] = __uint_as_float((unsigned)(stq[i] >> 32)); }
#pragma unroll
    for (int i = 0; i < 4; ++i) { const int id = F.tid + 512 * i, srow = id >> 3, pc = id & 7;
        const float mu = s1[i] * (1.0f / 1024.0f), var = fmaxf(s2[i] * (1.0f / 1024.0f) - mu * mu, 0.f), rs = 1.0f / sqrtf(var + EPS);
        v4u o;
        o.x = pk2((bflo(wv[i].x) - mu) * rs * g0.x + c0.x, (bfhi(wv[i].x) - mu) * rs * g0.y + c0.y); o.y = pk2((bflo(wv[i].y) - mu) * rs * g0.z + c0.z, (bfhi(wv[i].y) - mu) * rs * g0.w + c0.w);
        o.z = pk2((bflo(wv[i].z) - mu) * rs * g1.x + c1.x, (bfhi(wv[i].z) - mu) * rs * g1.y + c1.y); o.w = pk2((bflo(wv[i].w) - mu) * rs * g1.z + c1.z, (bfhi(wv[i].w) - mu) * rs * g1.w + c1.w);
        *(LAS v4u*)(stage + srow * 128 + pc * 16) = o; }
    v4u ugv[4], gbv[4];
#pragma unroll
    for (int i = 0; i < 4; ++i) { const int id = F.tid + 512 * i; const size_t off = (row_base + (id >> 3)) * D + 64 * h + 8 * (id & 7); ugv[i] = *(const v4u*)(UG + off); gbv[i] = *(const v4u*)(GB + off); }
    __syncthreads();
    f32x16 acc[2];
#pragma unroll
    for (int r = 0; r < 16; ++r) { acc[0][r] = 0.f; acc[1][r] = 0.f; }
    const lds_cptr abase = (lds_cptr)stage + cc * 16384 + (8 * hi + ((lane & 15) >> 2)) * 128 + (16 * ((lane >> 4) & 1) + 4 * (lane & 3)) * 2;
#pragma unroll
    for (int st = 0; st < 8; ++st) if (st < 2 * (tc + 1)) {
#pragma unroll
        for (int ct = 0; ct < 2; ++ct) { const lds_cptr ap = abase + st * 2048 + ct * 64;
            const bf16x8 af = cat8(vtr(ap), vtr(ap + 512));
            acc[ct] = __builtin_amdgcn_mfma_f32_32x32x16_bf16(af, wf[st], acc[ct], 0, 0, 0); }
    }
    __syncthreads();
    {   LAS unsigned char* mrow = stage + (32 * w + r32) * 144 + 8 * hi;
#pragma unroll
        for (int ct = 0; ct < 2; ++ct)
#pragma unroll
            for (int rg = 0; rg < 4; ++rg)
                *(LAS unsigned long long*)(mrow + (32 * ct + 8 * rg) * 2) = (unsigned long long)cvtpk(acc[ct][4 * rg] + bs, acc[ct][4 * rg + 1] + bs) | ((unsigned long long)cvtpk(acc[ct][4 * rg + 2] + bs, acc[ct][4 * rg + 3] + bs) << 32); }
    __syncthreads();
#pragma unroll
    for (int i = 0; i < 4; ++i) { const int id = F.tid + 512 * i, trow = id >> 3, pc = id & 7; const size_t off = (row_base + trow) * D + 64 * h + 8 * pc;
        const v4u mw = *(const LAS v4u*)(stage + trow * 144 + pc * 16);
        float yb[8];
        if (YB_GLOBAL) { const v4u yw = *(const v4u*)(YB + off); yb[0] = bflo(yw.x); yb[1] = bfhi(yw.x); yb[2] = bflo(yw.y); yb[3] = bfhi(yw.y); yb[4] = bflo(yw.z); yb[5] = bfhi(yw.z); yb[6] = bflo(yw.w); yb[7] = bfhi(yw.w); }
        else { const float rl = 1.0f / Lst[trow]; const f32x4 o0 = *(const LAS f32x4*)(Ost + trow * 68 + 8 * pc), o1 = *(const LAS f32x4*)(Ost + trow * 68 + 8 * pc + 4);
            yb[0] = o0.x * rl; yb[1] = o0.y * rl; yb[2] = o0.z * rl; yb[3] = o0.w * rl; yb[4] = o1.x * rl; yb[5] = o1.y * rl; yb[6] = o1.z * rl; yb[7] = o1.w * rl; }
        const float mx[8] = {bflo(mw.x), bfhi(mw.x), bflo(mw.y), bfhi(mw.y), bflo(mw.z), bfhi(mw.z), bflo(mw.w), bfhi(mw.w)};
        const float ug[8] = {bflo(ugv[i].x), bfhi(ugv[i].x), bflo(ugv[i].y), bfhi(ugv[i].y), bflo(ugv[i].z), bfhi(ugv[i].z), bflo(ugv[i].w), bfhi(ugv[i].w)};
        const float gb[8] = {bflo(gbv[i].x), bfhi(gbv[i].x), bflo(gbv[i].y), bfhi(gbv[i].y), bflo(gbv[i].z), bfhi(gbv[i].z), bflo(gbv[i].w), bfhi(gbv[i].w)};
        v4u o;
        o.x = cvtpk(ug[0] * mx[0] + gb[0] * yb[0], ug[1] * mx[1] + gb[1] * yb[1]); o.y = cvtpk(ug[2] * mx[2] + gb[2] * yb[2], ug[3] * mx[3] + gb[3] * yb[3]);
        o.z = cvtpk(ug[4] * mx[4] + gb[4] * yb[4], ug[5] * mx[5] + gb[5] * yb[5]); o.w = cvtpk(ug[6] * mx[6] + gb[6] * yb[6], ug[7] * mx[7] + gb[7] * yb[7]);
        *(v4u*)(MG + off) = o; }
    __syncthreads();
}
__device__ __forceinline__ void sgu_fast(Frame& F) {
    int bh, qb;
    for (int i = 0; p2_item(F.vcu, i, bh, qb); ++i) sgu_item<true>(F, bh >> 4, bh & 15, qb, F.lds + RING_OFF, nullptr, nullptr);
}

#define LBAR() asm volatile("s_waitcnt lgkmcnt(0)\n\ts_barrier" ::: "memory")
#define PBAR() asm volatile("s_barrier" ::: "memory")
constexpr int OP = 68;
constexpr int QP = 144;
constexpr int TB = 1280, TN = 1537;
constexpr int A_OST = 0, A_LST = 69632, A_MQ = 70656, A_CNT = 71680, A_LIST = 71808, A_LUT = 80000, A_Q = 86160, A_P = 123024, A_END = 156816;
constexpr int PB = 528, PBUF = 32 * PB;
static_assert(A_Q % 16 == 0 && A_P % 16 == 0 && A_LUT + TN * 4 <= A_Q && A_Q + 256 * QP == A_P && A_P + 2 * PBUF == A_END && A_END <= LDSCTL_OFF, "P2 LDS map");
__device__ __forceinline__ void attn_item(Frame& F, int b, int h, int own, int probe = 0) {
    LAS unsigned char* L = F.lds;
    LAS float* Ost = (LAS float*)(L + A_OST); LAS float* Lst = (LAS float*)(L + A_LST); LAS float* MQ = (LAS float*)(L + A_MQ); LAS int* cnt = (LAS int*)(L + A_CNT);
    LAS unsigned char* list = L + A_LIST; LAS float* km = (LAS float*)(L + A_P); LAS float* lut = (LAS float*)(L + A_LUT);
    const bf16 *Qb = (const bf16*)(F.ws + WS_Q) + ((size_t)b * SEQ + 256 * own) * D + 64 * h, *Kb = (const bf16*)(F.ws + WS_K) + (size_t)b * SEQ * D + 64 * h;
    const float *kmean = (const float*)(F.ws + WS_CTL + CT_KMEAN), *glut = (const float*)(F.ws + WS_LUT) + h * 1024, *rel = F.in[8];
    const unsigned* khmax = (const unsigned*)(F.ws + WS_CTL + CT_KHMAX);
    int tid_ = threadIdx.x; asm volatile("" : "+v"(tid_));
    const int tid = tid_, lane = tid & 63, r32 = lane & 31, hi = lane >> 5, w = F.wave, l15 = lane & 15, kg = lane >> 4, ds = w & 3;
    const bf16 *Kf = (const bf16*)(F.ws + WS_K) + (size_t)(b * 16 + h) * (32 * 16384), *Vf = (const bf16*)(F.ws + WS_VA) + (size_t)(b * 16 + h) * (32 * 16384);
    u32x4_t f0[8];
    if (w < 4) { const bf16* kp_ = Kf + w * 4096 + lane * 8;
#pragma unroll
        for (int t = 0; t < 2; ++t)
#pragma unroll
            for (int ks = 0; ks < 4; ++ks) f0[4 * t + ks] = *(const u32x4_t*)(kp_ + t * 2048 + ks * 512); }
    else { const bf16* vp_ = Vf + ds * 4096 + lane * 8;
#pragma unroll
        for (int st = 0; st < 8; ++st) f0[st] = *(const u32x4_t*)(vp_ + st * 512); }
    float kmv[4], tbv[4]; v4u qv[4];
#pragma unroll
    for (int j = 0; j < 4; ++j) { const int i = tid + 512 * j; kmv[j] = i < own * 64 ? kmean[(size_t)(b * 32 + (i >> 6)) * D + 64 * h + (i & 63)] : 0.f; }
#pragma unroll
    for (int j = 0; j < 4; ++j) { const int i = tid + 512 * j; const int dist = TB - i; tbv[j] = (i < TN && dist >= 0) ? glut[dist < 1023 ? dist : 1023] : -INFINITY; }
#pragma unroll
    for (int i = 0; i < 4; ++i) { const int id = tid + 512 * i; qv[i] = *(const v4u*)(Qb + (size_t)(id >> 3) * D + 8 * (id & 7)); }
    const float maxbl = ((const float*)(F.ws + WS_LUT))[16 * 1024 + h], khm0 = __uint_as_float(khmax[b * 32 + 2 * h]), khm1 = __uint_as_float(khmax[b * 32 + 2 * h + 1]);
    for (int i = tid; i < 256 * OP; i += 512) Ost[i] = 0.f;
    if (tid < 256) Lst[tid] = 0.f;
    if (tid < 32) cnt[tid] = 0;
#pragma unroll
    for (int j = 0; j < 4; ++j) { const int i = tid + 512 * j; if (i < own * 64) km[i] = kmv[j]; }
#pragma unroll
    for (int j = 0; j < 4; ++j) { const int i = tid + 512 * j; if (i < TN) lut[i] = tbv[j]; }
#pragma unroll
    for (int i = 0; i < 4; ++i) { const int id = tid + 512 * i; *(LAS v4u*)(L + A_Q + (id >> 3) * QP + (id & 7) * 16) = qv[i]; }
    __syncthreads();
    {
        const LAS unsigned char* qp = L + A_Q + (32 * w + r32) * QP + 16 * hi;
        bf16x8 qf[4];
#pragma unroll
        for (int ks = 0; ks < 4; ++ks) qf[ks] = *(const LAS bf16x8*)(qp + 32 * ks);
        f32x16 G;
#pragma unroll
        for (int r = 0; r < 16; ++r) G[r] = 0.f;
        const LAS float* kr = km + r32 * 64 + 8 * hi;
#pragma unroll
        for (int ks = 0; ks < 4; ++ks) { const f32x4 a = *(const LAS f32x4*)(kr + 16 * ks), c = *(const LAS f32x4*)(kr + 16 * ks + 4);
            const float x[8] = {a.x, a.y, a.z, a.w, c.x, c.y, c.z, c.w}; unsigned hb[8], lb[8];
#pragma unroll
            for (int j = 0; j < 8; ++j) { hb[j] = f2bf(x[j]); lb[j] = f2bf(x[j] - __uint_as_float(hb[j] << 16)); }
            u32x4_t hw, lw; hw.x = hb[0] | (hb[1] << 16); hw.y = hb[2] | (hb[3] << 16); hw.z = hb[4] | (hb[5] << 16); hw.w = hb[6] | (hb[7] << 16);
            lw.x = lb[0] | (lb[1] << 16); lw.y = lb[2] | (lb[3] << 16); lw.z = lb[4] | (lb[5] << 16); lw.w = lb[6] | (lb[7] << 16);
            G = __builtin_amdgcn_mfma_f32_32x32x16_bf16(__builtin_bit_cast(bf16x8, hw), qf[ks], G, 0, 0, 0);
            G = __builtin_amdgcn_mfma_f32_32x32x16_bf16(__builtin_bit_cast(bf16x8, lw), qf[ks], G, 0, 0, 0); }
        float nlo = 0.f, nhi = 0.f;
#pragma unroll
        for (int ks = 0; ks < 4; ++ks) { const u32x4_t qw = __builtin_bit_cast(u32x4_t, qf[ks]);
            const float e[8] = {bflo(qw.x), bfhi(qw.x), bflo(qw.y), bfhi(qw.y), bflo(qw.z), bfhi(qw.z), bflo(qw.w), bfhi(qw.w)}; float t = 0.f;
#pragma unroll
            for (int j = 0; j < 8; ++j) t += e[j] * e[j];
            if (ks < 2) nlo += t; else nhi += t; }
        nlo += __shfl_xor(nlo, 32); nhi += __shfl_xor(nhi, 32);
        if (hi == 0) MQ[32 * w + r32] = sqrtf(nlo) * khm0 + sqrtf(nhi) * khm1 + maxbl + 0.01f;
        float v0 = -INFINITY, v1 = -INFINITY, v2 = -INFINITY; int i0 = 64, i1 = 64, i2 = 64;
#pragma unroll
        for (int r = 0; r < 16; ++r) { const int n = (r & 3) + 8 * (r >> 2) + 4 * hi; const float g = n < own ? G[r] : -INFINITY;
            if (g > v0) { v2 = v1; i2 = i1; v1 = v0; i1 = i0; v0 = g; i0 = n; } else if (g > v1) { v2 = v1; i2 = i1; v1 = g; i1 = n; } else if (g > v2) { v2 = g; i2 = n; } }
        const float pv[3] = {__shfl_xor(v0, 32), __shfl_xor(v1, 32), __shfl_xor(v2, 32)}; const int pi[3] = {__shfl_xor(i0, 32), __shfl_xor(i1, 32), __shfl_xor(i2, 32)};
#pragma unroll
        for (int k = 0; k < 3; ++k) { const float g = pv[k]; const int n = pi[k];
            if (g > v0 || (g == v0 && n < i0)) { v2 = v1; i2 = i1; v1 = v0; i1 = i0; v0 = g; i0 = n; }
            else if (g > v1 || (g == v1 && n < i1)) { v2 = v1; i2 = i1; v1 = g; i1 = n; }
            else if (g > v2 || (g == v2 && n < i2)) { v2 = g; i2 = n; } }
        if (hi == 0) { const int qid = 32 * w + r32;
            if (v0 > -INFINITY) { const int pos = __hip_atomic_fetch_add(cnt + i0, 1, __ATOMIC_RELAXED, __HIP_MEMORY_SCOPE_WORKGROUP); list[i0 * 256 + pos] = (unsigned char)qid; }
            if (v1 > -INFINITY) { const int pos = __hip_atomic_fetch_add(cnt + i1, 1, __ATOMIC_RELAXED, __HIP_MEMORY_SCOPE_WORKGROUP); list[i1 * 256 + pos] = (unsigned char)qid; }
            if (v2 > -INFINITY) { const int pos = __hip_atomic_fetch_add(cnt + i2, 1, __ATOMIC_RELAXED, __HIP_MEMORY_SCOPE_WORKGROUP); list[i2 * 256 + pos] = (unsigned char)qid; } }
    }
    __syncthreads();
    const float bias31 = lut[TB - 1023];
#define NCHUNKS(n_) ((n_) == own ? 8 : max(1, (cnt[(n_)] + 31) >> 5))
    if (!(probe & 1)) {
    if (w < 4) {
        float mitem = fmaxf(fmaxf(MQ[lane], MQ[lane + 64]), fmaxf(MQ[lane + 128], MQ[lane + 192])); mitem = wave_max(mitem);
        const bool useshift = mitem > 96.0f;
        const float shift = useshift ? mitem - 64.0f : 0.f;
        const f32x16 zero16 = {0.f, 0.f, 0.f, 0.f, 0.f, 0.f, 0.f, 0.f, 0.f, 0.f, 0.f, 0.f, 0.f, 0.f, 0.f, 0.f};
        const LAS unsigned char* qrd = L + A_Q + 16 * hi;
        LAS unsigned char* pwr_base = L + A_P + r32 * PB + 128 * w + 8 * hi;
        const bf16* Kw = Kf + w * 4096 + lane * 8;
        u32x4_t kA[2][4], kB[2][4];
        int buf = 0;
#define LOAD_K(dst, n_) do { const int nn_ = (probe & 4) ? 0 : ((n_) < own ? (n_) : own); const bf16* kp0_ = Kw + (size_t)nn_ * 16384; const bf16* kp1_ = kp0_ + 2048; \
        asm volatile("global_load_dwordx4 %0, %1, off" : "=v"(dst[0][0]) : "v"(kp0_)); asm volatile("global_load_dwordx4 %0, %1, off offset:1024" : "=v"(dst[0][1]) : "v"(kp0_)); \
        asm volatile("global_load_dwordx4 %0, %1, off offset:2048" : "=v"(dst[0][2]) : "v"(kp0_)); asm volatile("global_load_dwordx4 %0, %1, off offset:3072" : "=v"(dst[0][3]) : "v"(kp0_)); \
        asm volatile("global_load_dwordx4 %0, %1, off" : "=v"(dst[1][0]) : "v"(kp1_)); asm volatile("global_load_dwordx4 %0, %1, off offset:1024" : "=v"(dst[1][1]) : "v"(kp1_)); \
        asm volatile("global_load_dwordx4 %0, %1, off offset:2048" : "=v"(dst[1][2]) : "v"(kp1_)); asm volatile("global_load_dwordx4 %0, %1, off offset:3072" : "=v"(dst[1][3]) : "v"(kp1_)); } while (0)
#define WAIT_K(x) asm volatile("s_waitcnt vmcnt(8)" : "+v"(x[0][0]), "+v"(x[0][1]), "+v"(x[0][2]), "+v"(x[0][3]), "+v"(x[1][0]), "+v"(x[1][1]), "+v"(x[1][2]), "+v"(x[1][3]) :: "memory")
#define QK_BLOCK(n_, kf) do { const int nq = (n_); const bool isown = nq == own; const int count = isown ? 256 : qcnt; \
        const int ncq = __builtin_amdgcn_readfirstlane(isown ? 8 : max(1, (qcnt + 31) >> 5)); const bool near = (own - nq) <= 4; \
        const int ncnt_ = cnt[nq < 31 ? nq + 1 : 31];                     \
        for (int cq = 0; cq < ncq; ++cq) { \
            LAS unsigned char* pw = pwr_base + buf * PBUF; \
            const int li = 32 * cq + r32; \
            const int qi = isown ? li : (li < count ? qe : 0); \
            const int ne_ = (cq + 1 < ncq) ? (int)list[nq * 256 + li + 32] : (int)list[(nq + 1) * 256 + r32];     \
            if (probe & 8) { } else if (isown && 64 * w > 32 * cq + 31) {                         \
                _Pragma("unroll") for (int g = 0; g < 4; ++g) { *(LAS unsigned long long*)(pw + g * 16) = 0ull; *(LAS unsigned long long*)(pw + 64 + g * 16) = 0ull; } \
            } else { \
            const LAS unsigned char* qp = qrd + qi * QP; bf16x8 qf[4]; \
            _Pragma("unroll") for (int ks = 0; ks < 4; ++ks) qf[ks] = *(const LAS bf16x8*)(qp + 32 * ks); \
            const LAS float* tb = lut + (TB - (256 * (own - nq) + qi - 64 * w - 4 * hi)); \
            f32x16 S0 = __builtin_amdgcn_mfma_f32_32x32x16_bf16(__builtin_bit_cast(bf16x8, kf[0][0]), qf[0], zero16, 0, 0, 0); \
            f32x16 S1 = __builtin_amdgcn_mfma_f32_32x32x16_bf16(__builtin_bit_cast(bf16x8, kf[1][0]), qf[0], zero16, 0, 0, 0); \
            _Pragma("unroll") for (int ks = 1; ks < 4; ++ks) { S0 = __builtin_amdgcn_mfma_f32_32x32x16_bf16(__builtin_bit_cast(bf16x8, kf[0][ks]), qf[ks], S0, 0, 0, 0); S1 = __builtin_amdgcn_mfma_f32_32x32x16_bf16(__builtin_bit_cast(bf16x8, kf[1][ks]), qf[ks], S1, 0, 0, 0); } \
            if (useshift) { _Pragma("unroll") for (int r = 0; r < 16; ++r) { S0[r] -= shift; S1[r] -= shift; } } \
            if (near) { _Pragma("unroll") for (int r = 0; r < 16; ++r) S0[r] += tb[(r & 3) + 8 * (r >> 2)]; } \
            _Pragma("unroll") for (int r = 0; r < 16; ++r) S0[r] = __builtin_amdgcn_exp2f(S0[r]); \
            _Pragma("unroll") for (int g = 0; g < 4; ++g) \
                *(LAS unsigned long long*)(pw + g * 16) = (unsigned long long)cvtpk(S0[4 * g], S0[4 * g + 1]) | ((unsigned long long)cvtpk(S0[4 * g + 2], S0[4 * g + 3]) << 32); \
            asm volatile("" ::: "memory");                                 \
            if (near) { _Pragma("unroll") for (int r = 0; r < 16; ++r) S1[r] += tb[32 + (r & 3) + 8 * (r >> 2)]; } \
            _Pragma("unroll") for (int r = 0; r < 16; ++r) S1[r] = __builtin_amdgcn_exp2f(S1[r]); \
            _Pragma("unroll") for (int g = 0; g < 4; ++g) \
                *(LAS unsigned long long*)(pw + 64 + g * 16) = (unsigned long long)cvtpk(S1[4 * g], S1[4 * g + 1]) | ((unsigned long long)cvtpk(S1[4 * g + 2], S1[4 * g + 3]) << 32); \
            } \
            qe = ne_; \
            LBAR(); \
            buf ^= 1; } \
        qcnt = ncnt_; } while (0)
        int qe = (int)list[r32], qcnt = cnt[0];
#pragma unroll
        for (int t = 0; t < 2; ++t)
#pragma unroll
            for (int ks = 0; ks < 4; ++ks) kA[t][ks] = f0[4 * t + ks];
        for (int n = 0; ; n += 2) {
            LOAD_K(kB, n + 1); WAIT_K(kA); QK_BLOCK(n, kA);
            if (n + 1 > own) break;
            LOAD_K(kA, n + 2); WAIT_K(kB); QK_BLOCK(n + 1, kB);
            if (n + 2 > own) break;
        }
        asm volatile("s_waitcnt vmcnt(0)" ::: "memory");
        LBAR();
#undef WAIT_K
#undef LOAD_K
#undef QK_BLOCK
    } else {
        const LAS unsigned char* prd_base = L + A_P + l15 * PB + kg * 16;
        const bf16* Vw = Vf + ds * 4096 + lane * 8;
        const float sc31 = __builtin_amdgcn_exp2f(bias31);
        const bf16x8 ones = {(short)0x3f80, (short)0x3f80, (short)0x3f80, (short)0x3f80, (short)0x3f80, (short)0x3f80, (short)0x3f80, (short)0x3f80};
        u32x4_t vA[8], vB[8];
        int buf = 0;
#define LOAD_VT(dst, n_) do { const int nn_ = (probe & 4) ? 0 : ((n_) < own ? (n_) : own); const bf16* vp_ = Vw + (size_t)nn_ * 16384; const bf16* vq_ = vp_ + 2048; \
        asm volatile("global_load_dwordx4 %0, %1, off" : "=v"(dst[0]) : "v"(vp_)); asm volatile("global_load_dwordx4 %0, %1, off offset:1024" : "=v"(dst[1]) : "v"(vp_)); \
        asm volatile("global_load_dwordx4 %0, %1, off offset:2048" : "=v"(dst[2]) : "v"(vp_)); asm volatile("global_load_dwordx4 %0, %1, off offset:3072" : "=v"(dst[3]) : "v"(vp_)); \
        asm volatile("global_load_dwordx4 %0, %1, off" : "=v"(dst[4]) : "v"(vq_)); asm volatile("global_load_dwordx4 %0, %1, off offset:1024" : "=v"(dst[5]) : "v"(vq_)); \
        asm volatile("global_load_dwordx4 %0, %1, off offset:2048" : "=v"(dst[6]) : "v"(vq_)); asm volatile("global_load_dwordx4 %0, %1, off offset:3072" : "=v"(dst[7]) : "v"(vq_)); } while (0)
#define WAIT_V(x) asm volatile("s_waitcnt vmcnt(8)" : "+v"(x[0]), "+v"(x[1]), "+v"(x[2]), "+v"(x[3]), "+v"(x[4]), "+v"(x[5]), "+v"(x[6]), "+v"(x[7]) :: "memory")
#define PV_BLOCK(n_, vfr) do { const int np = (n_); const bool isown = np == own; const int count = isown ? 256 : pcnt; \
        const int ncp = __builtin_amdgcn_readfirstlane(isown ? 8 : max(1, (pcnt + 31) >> 5)); const float scf = (own - np) <= 4 ? 1.0f : sc31; \
        const int ncnt_ = cnt[np < 31 ? np + 1 : 31]; \
        for (int cp = 0; cp < ncp; ++cp) { \
            const int li0 = 32 * cp + l15, li1 = li0 + 16; const bool valid0 = li0 < count, valid1 = li1 < count; \
            const int qi0 = isown ? li0 : (valid0 ? pe0 : 0), qi1 = isown ? li1 : (valid1 ? pe1 : 0); \
            const LAS unsigned char* nl_ = (cp + 1 < ncp) ? (list + np * 256 + li0 + 32) : (list + (np + 1) * 256 + l15); \
            const int ne0_ = (int)nl_[0], ne1_ = (int)nl_[16]; \
            if (!(probe & 16)) { \
            const LAS unsigned char* pr = prd_base + buf * PBUF; \
            LAS f32x4* op0 = (LAS f32x4*)(Ost + qi0 * OP + 16 * ds + 4 * kg); LAS f32x4* op1 = (LAS f32x4*)(Ost + qi1 * OP + 16 * ds + 4 * kg); \
            if (count - 32 * cp <= 16) {                                   \
            bf16x8 p0[4]; \
            _Pragma("unroll") for (int st = 0; st < 4; ++st) p0[st] = *(const LAS bf16x8*)(pr + st * 64); \
            const f32x4 o0 = *op0; \
            f32x4 a0 = {0.f, 0.f, 0.f, 0.f}, l0 = {0.f, 0.f, 0.f, 0.f}; \
            _Pragma("unroll") for (int st = 0; st < 4; ++st) { a0 = __builtin_amdgcn_mfma_f32_16x16x32_bf16(__builtin_bit_cast(bf16x8, vfr[st]), p0[st], a0, 0, 0, 0); \
                if (ds == 0) l0 = __builtin_amdgcn_mfma_f32_16x16x32_bf16(ones, p0[st], l0, 0, 0, 0); } \
            _Pragma("unroll") for (int st = 0; st < 4; ++st) p0[st] = *(const LAS bf16x8*)(pr + (4 + st) * 64); \
            _Pragma("unroll") for (int st = 0; st < 4; ++st) { a0 = __builtin_amdgcn_mfma_f32_16x16x32_bf16(__builtin_bit_cast(bf16x8, vfr[4 + st]), p0[st], a0, 0, 0, 0); \
                if (ds == 0) l0 = __builtin_amdgcn_mfma_f32_16x16x32_bf16(ones, p0[st], l0, 0, 0, 0); } \
            if (ds == 0 && kg == 0) { if (valid0) Lst[qi0] += l0[0] * scf; } \
            if (valid0) *op0 = o0 + a0 * scf; \
            } else { \
            bf16x8 p0[4], p1[4]; \
            _Pragma("unroll") for (int st = 0; st < 4; ++st) { p0[st] = *(const LAS bf16x8*)(pr + st * 64); p1[st] = *(const LAS bf16x8*)(pr + 16 * PB + st * 64); } \
            const f32x4 o0 = *op0, o1 = *op1; \
            f32x4 a0 = {0.f, 0.f, 0.f, 0.f}, a1 = {0.f, 0.f, 0.f, 0.f}, l0 = {0.f, 0.f, 0.f, 0.f}, l1 = {0.f, 0.f, 0.f, 0.f}; \
            _Pragma("unroll") for (int st = 0; st < 4; ++st) { \
                a0 = __builtin_amdgcn_mfma_f32_16x16x32_bf16(__builtin_bit_cast(bf16x8, vfr[st]), p0[st], a0, 0, 0, 0); a1 = __builtin_amdgcn_mfma_f32_16x16x32_bf16(__builtin_bit_cast(bf16x8, vfr[st]), p1[st], a1, 0, 0, 0); \
                if (ds == 0) { l0 = __builtin_amdgcn_mfma_f32_16x16x32_bf16(ones, p0[st], l0, 0, 0, 0); l1 = __builtin_amdgcn_mfma_f32_16x16x32_bf16(ones, p1[st], l1, 0, 0, 0); } } \
            _Pragma("unroll") for (int st = 0; st < 4; ++st) { p0[st] = *(const LAS bf16x8*)(pr + (4 + st) * 64); p1[st] = *(const LAS bf16x8*)(pr + 16 * PB + (4 + st) * 64); } \
            _Pragma("unroll") for (int st = 0; st < 4; ++st) { \
                a0 = __builtin_amdgcn_mfma_f32_16x16x32_bf16(__builtin_bit_cast(bf16x8, vfr[4 + st]), p0[st], a0, 0, 0, 0); a1 = __builtin_amdgcn_mfma_f32_16x16x32_bf16(__builtin_bit_cast(bf16x8, vfr[4 + st]), p1[st], a1, 0, 0, 0); \
                if (ds == 0) { l0 = __builtin_amdgcn_mfma_f32_16x16x32_bf16(ones, p0[st], l0, 0, 0, 0); l1 = __builtin_amdgcn_mfma_f32_16x16x32_bf16(ones, p1[st], l1, 0, 0, 0); } } \
            if (ds == 0 && kg == 0) { if (valid0) Lst[qi0] += l0[0] * scf; if (valid1) Lst[qi1] += l1[0] * scf; } \
            if (valid0) *op0 = o0 + a0 * scf; \
            if (valid1) *op1 = o1 + a1 * scf; \
            } \
            } \
            pe0 = ne0_; pe1 = ne1_; \
            PBAR(); \
            buf ^= 1; } \
        pcnt = ncnt_; } while (0)
        int pe0 = (int)list[l15], pe1 = (int)list[16 + l15], pcnt = cnt[0];
#pragma unroll
        for (int st = 0; st < 8; ++st) vA[st] = f0[st];
        LBAR();
        for (int n = 0; ; n += 2) {
            LOAD_VT(vB, n + 1); WAIT_V(vA); PV_BLOCK(n, vA);
            if (n + 1 > own) break;
            LOAD_VT(vA, n + 2); WAIT_V(vB); PV_BLOCK(n + 1, vB);
            if (n + 2 > own) break;
        }
        asm volatile("s_waitcnt vmcnt(0)" ::: "memory");
#undef WAIT_V
#undef LOAD_VT
#undef PV_BLOCK
    }
    }
#undef NCHUNKS
}
__device__ __forceinline__ void p2_fast(Frame& F, int probe = 0) {
    int bh, qb;
    for (int v = F.vcu; v < 256; v += F.G) for (int i = 0; p2_item(v, i, bh, qb); ++i) { attn_item(F, bh >> 4, bh & 15, qb, probe);
        if (!(probe & 2)) sgu_item<false>(F, bh >> 4, bh & 15, qb, F.lds + A_Q, (const LAS float*)(F.lds + A_OST), (const LAS float*)(F.lds + A_LST)); }
}
__device__ __forceinline__ void final_norm(Frame& F) {
    const float *X3 = (const float*)(F.ws + WS_X1), *ss4 = (const float*)(F.ws + WS_CTL + CT_SS4), *gf = F.in[16];
    const int gw = F.vcu * NWAVES + F.wave, NGW = F.G * NWAVES;
    f32x4 gv[4];
#pragma unroll
    for (int j = 0; j < 4; ++j) gv[j] = ((const f32x4*)gf)[F.lane + 64 * j];
    for (int m = gw; m < M; m += NGW) { const float rs = 1.0f / sqrtf(ss4[m] * (1.0f / D) + EPS);
        const f32x4* xr = (const f32x4*)(X3 + (size_t)m * D) + F.lane; f32x4* o = (f32x4*)(F.out + (size_t)m * D) + F.lane;
#pragma unroll
        for (int j = 0; j < 4; ++j) o[64 * j] = xr[64 * j] * rs * gv[j]; }
}

#ifndef MK_N_LAUNCHES
#define MK_N_LAUNCHES 1
#endif
constexpr int N_PHASES = 8;
#ifndef PROBE_P2
#define PROBE_P2 -1
#endif
#ifndef P2FAST
#define P2FAST 1
#endif
struct Args { const float* in[17]; float* out; unsigned char* ws; int ph_lo, ph_hi; };
__global__ void __launch_bounds__(NWAVES * 64, 2) mk_fwd(Args args) {
    extern __shared__ __attribute__((aligned(16))) unsigned char lds[];
    Frame F;
    F.lds = (LAS unsigned char*)lds; F.MISC = (volatile LAS unsigned*)(F.lds + MISC_OFF);
    F.tid = threadIdx.x; F.lane = F.tid & 63; F.wave = __builtin_amdgcn_readfirstlane(F.tid >> 6);
    F.G = gridDim.x; { const int bx = blockIdx.x; F.vcu = (F.G % 8 == 0) ? (bx % 8) * (F.G / 8) + bx / 8 : bx; }
    F.ws = args.ws; F.out = args.out;
#pragma unroll
    for (int i = 0; i < 17; ++i) F.in[i] = args.in[i];
    for (int u = F.tid; u < (LDS_BYTES - LDSCTL_OFF) / 4; u += NWAVES * 64) ((LAS unsigned*)(F.lds + LDSCTL_OFF))[u] = 0u;
    __syncthreads();
    unsigned* barw = (unsigned*)(F.ws + WS_CTL + CT_BAR);
    XcdBarrier bar; bar.bar = barw; bar.x = 0; bar.st = nullptr;
    if (MK_N_LAUNCHES == 1) bar = xcd_barrier_post(barw, F.MISC + 8);
    const int lo = args.ph_lo, hi = args.ph_hi;
#define IN(k) (lo <= (k) && (k) < hi)
#define SEAM(k) do { if (IN(k) && IN((k) + 1)) xcd_barrier(bar); } while (0)
#define LSEAM(k) do { if (IN(k) && IN((k) + 1)) { if (grp_ok) grp_barrier(bar, blockIdx.x & 7u); else xcd_barrier(bar); } } while (0)
    bool grp_ok = false;
    float* ctl = (float*)(F.ws + WS_CTL);
    bf16* d0 = (bf16*)F.out; bf16* d1 = (bf16*)((unsigned char*)F.out + 32 * MiB);
    if (IN(0)) { p0_prologue(F, 0); } SEAM(0);
    if (IN(1)) {
        pg8::Gemm g{d0, (const bf16*)(F.ws + WS_WIN), M, NIN, D}; pg8::StaticOrder S; S.init(M, NIN, F.G, (int)blockIdx.x);
        pg8::EpiIn E{(bf16*)(F.ws + WS_UG), (bf16*)(F.ws + WS_VS), (bf16*)(F.ws + WS_Q), (bf16*)(F.ws + WS_K), (bf16*)(F.ws + WS_VA), (bf16*)(F.ws + WS_GB),
                     (float*)(F.ws + WS_CTL + CT_STATS1), (float*)(F.ws + WS_CTL + CT_KMEAN), (unsigned*)(F.ws + WS_CTL + CT_KHMAX), F.lds + RING_BYTES};
        pg8::gemm_phase<pg8::EpiIn, pg8::StaticOrder, true, true>(F.lds + RING_OFF, g, S, E);
    } SEAM(1);
    if (IN(2)) { if (P2FAST) { if (PROBE_P2 >= 0) { int nrep = 2; asm volatile("" : "+s"(nrep)); for (int rep = 0; rep < nrep; ++rep) p2_fast(F, rep + 1 < nrep ? PROBE_P2 : 0); } else p2_fast(F, 0); p0_prologue(F, 1); } else { attn_simple(F); p0_prologue(F, 1); } } SEAM(2);
    if (IN(3)) { if (!P2FAST) sgu_fast(F); } if (!P2FAST || MK_N_LAUNCHES != 1) SEAM(3);
    if (MK_N_LAUNCHES == 1 && IN(4)) grp_ok = grp_local_ok(bar, F.MISC + 10);
    if (IN(4)) {
        pg8::Gemm g{d0, (const bf16*)(F.ws + WS_WOUT), M, D, D}; pg8::StaticOrder S; S.init(M, D, F.G, (int)blockIdx.x);
        pg8::EpiResid<false> E{F.in[0], d1, (float*)(F.ws + WS_CTL + CT_SS2), d1, 1 << 30};
        pg8::gemm_phase<pg8::EpiResid<false>, pg8::StaticOrder, true, true>(F.lds + RING_OFF, g, S, E);
    } LSEAM(4);
    if (IN(5)) {
        pg8::Gemm g{d1, (const bf16*)(F.ws + WS_W1), M, FF, D}; pg8::StaticOrder S; S.init(M, FF, F.G, (int)blockIdx.x);
        pg8::EpiFF1 E{(bf16*)(F.ws + WS_A), (const float*)(F.ws + WS_CTL + CT_SS2), EPS};
        pg8::gemm_phase<pg8::EpiFF1, pg8::StaticOrder, true, true>(F.lds + RING_OFF, g, S, E);
    } LSEAM(5);
    if (IN(6)) {
        pg8::Gemm g{(const bf16*)(F.ws + WS_A), (const bf16*)(F.ws + WS_W2), M, D, FF}; pg8::StaticOrder S; S.init(M, D, F.G, (int)blockIdx.x);
        pg8::EpiResid<true> E{d1, (bf16*)(F.ws + WS_X2B_LO), (float*)(F.ws + WS_CTL + CT_SS3), (bf16*)(F.ws + WS_X2B_HI), 8192};
        pg8::gemm_phase<pg8::EpiResid<true>, pg8::StaticOrder, true, true>(F.lds + RING_OFF, g, S, E);
    } SEAM(6);
    if (IN(7)) {
        { int kple = PLE; asm volatile("" : "+s"(kple));
          pg8::Gemm g{(const bf16*)(F.ws + WS_PB), (const bf16*)(F.ws + WS_WP), M, D, kple}; pg8::StaticOrder S; S.init(M, D, F.G, (int)blockIdx.x);
          pg8::EpiStore E{(bf16*)(F.ws + WS_A)};
          pg8::gemm_phase<pg8::EpiStore, pg8::StaticOrder, true, true>(F.lds + RING_OFF, g, S, E); }
        asm volatile("s_waitcnt vmcnt(0)" ::: "memory"); __syncthreads();
        { pg8::Gemm g{(const bf16*)(F.ws + WS_X2B_LO), (const bf16*)(F.ws + WS_WG), M, D, D, (const bf16*)(F.ws + WS_X2B_HI), 32}; pg8::StaticOrder S; S.init(M, D, F.G, (int)blockIdx.x);
          pg8::EpiPle E{(const bf16*)(F.ws + WS_X2B_LO), (const bf16*)(F.ws + WS_X2B_HI), 8192, (const bf16*)(F.ws + WS_A), (const float*)(F.ws + WS_CTL + CT_SS3), (float*)(F.ws + WS_CTL + CT_SS4), EPS, (unsigned*)(F.ws + WS_CTL + CT_PCNT), F.in[16], F.out};
          pg8::gemm_phase<pg8::EpiPle, pg8::StaticOrder, true, true>(F.lds + RING_OFF, g, S, E); }
    }
    (void)ctl;
#undef IN
#undef SEAM
#undef LSEAM
}

extern "C" void kernel_launch(void* const* d_in, const int* in_sizes, int n_in, void* d_out, int out_size, void* d_ws, size_t ws_size, hipStream_t stream) {
    static int grid = 0;
    if (grid == 0) {
        if (n_in != 17 || in_sizes[0] != M * D || out_size != M * D || ws_size < WS_END) { fprintf(stderr, "kernel_launch: unexpected shapes (n_in %d, in0 %d, out %d, ws %zu); nothing launched\n", n_in, n_in > 0 ? in_sizes[0] : -1, out_size, ws_size); grid = -1; return; }
        int dev = 0, cus = 0, per_cu = 0;
        if (hipGetDevice(&dev) != hipSuccess || hipDeviceGetAttribute(&cus, hipDeviceAttributeMultiprocessorCount, dev) != hipSuccess) { grid = -1; return; }
        if (hipFuncSetAttribute((const void*)mk_fwd, hipFuncAttributeMaxDynamicSharedMemorySize, LDS_BYTES) != hipSuccess) { fprintf(stderr, "kernel_launch: hipFuncSetAttribute failed\n"); grid = -1; return; }
        if (hipOccupancyMaxActiveBlocksPerMultiprocessor(&per_cu, (const void*)mk_fwd, NWAVES * 64, LDS_BYTES) != hipSuccess || per_cu < 1) fprintf(stderr, "kernel_launch: note: occupancy query reports %d blocks per CU\n", per_cu);
        (void)hipGetLastError();
        grid = cus > 256 ? 256 : cus;
    }
    if (grid < 0) return;
    if (hipMemsetAsync((char*)d_ws + WS_CTL, 0, CTL_ZERO_BYTES, stream) != hipSuccess) { fprintf(stderr, "kernel_launch: memset failed\n"); return; }
    Args a{};
    for (int i = 0; i < 17; ++i) a.in[i] = (const float*)d_in[i];
    a.out = (float*)d_out; a.ws = (unsigned char*)d_ws;
    if (MK_N_LAUNCHES == 1) { a.ph_lo = 0; a.ph_hi = N_PHASES; hipLaunchKernelGGL(mk_fwd, dim3(grid), dim3(NWAVES * 64), LDS_BYTES, stream, a); }
    else for (int ph = 0; ph < N_PHASES; ++ph) { a.ph_lo = ph; a.ph_hi = ph + 1; hipLaunchKernelGGL(mk_fwd, dim3(grid), dim3(NWAVES * 64), LDS_BYTES, stream, a); }
}
```

```cpp
#include <hip/hip_runtime.h>
#include <cstdio>
#include <cstdint>
#include <cmath>
namespace pg8 {
#define PG8_LAS __attribute__((address_space(3)))
typedef unsigned short bf16_t;
typedef short bf16x8 __attribute__((ext_vector_type(8)));
typedef float f32x4 __attribute__((ext_vector_type(4)));
typedef unsigned u32x4 __attribute__((ext_vector_type(4)));
constexpr int BM = 256, BK = 64, HALF = 128, HTB = HALF * BK * 2  , STAGE_BYTES = 8 * HTB, NXCD = 8, WGM = 8;

__host__ __device__ __forceinline__ int lds_byte(int r, int c) { const int st = (r >> 4) * 2 + (c >> 5), rr = r & 15, cc = c & 31, ob = rr * 64 + cc * 2; return st * 1024 + (ob ^ (((ob >> 9) & 1) << 5)); }
__host__ __device__ __forceinline__ void stage_rc(int b, int& R, int& C) { const int st = b / 1024, sb = b % 1024, swz = sb ^ (((sb >> 9) & 1) << 5); R = (st >> 1) * 16 + swz / 64; C = (st & 1) * 32 + (swz % 64) / 2; }
__host__ __device__ __forceinline__ int perm32(int rho) { const int n = rho >> 4, i = rho & 15; return 8 * (i >> 2) + 4 * n + (i & 3); }

struct Unit { int pm, pn; };
struct Gemm { const bf16_t* A; const bf16_t* Bt; int M, N, K; const bf16_t* A2 = nullptr; int pm2 = 1 << 30; };

struct StaticOrder {
    int nM, nN, nwg, G, c;
    __host__ __device__ void init(int M, int N, int G_, int c_) { nM = M / BM; nN = N / BM; nwg = nM * nN; G = G_; c = c_; }
    __host__ __device__ bool next(int i, Unit& u) const {
        const long L = (long)i * G + c; if (L >= nwg) return false;
        int wgid = (int)L; { const int q = nwg / NXCD, r = nwg % NXCD, xcd = wgid % NXCD, off = wgid / NXCD; wgid = (xcd < r ? xcd * (q + 1) : r * (q + 1) + (xcd - r) * q) + off; }
        const int nig = WGM * nN, gid = wgid / nig, fm = gid * WGM, gsz = (nM - fm) < WGM ? (nM - fm) : WGM;
        u.pm = fm + ((wgid % nig) % gsz); u.pn = (wgid % nig) / gsz; return true;
    }
    __device__ __forceinline__ void a_ready(const Unit&) const {}
    __device__ __forceinline__ void done(const Unit&) const {}
};

__device__ __forceinline__ unsigned cvt_pk_bf16(float lo, float hi) { unsigned r; asm volatile("v_cvt_pk_bf16_f32 %0, %1, %2" : "=v"(r) : "v"(lo), "v"(hi)); return r; }
typedef float f32x2 __attribute__((ext_vector_type(2)));
__device__ __forceinline__ f32x2 gelu_pk(f32x2 v) {
    const f32x2 av = __builtin_elementwise_abs(v), d = av * 0.2316418882f + 1.0f;
    f32x2 t; t.x = __builtin_amdgcn_rcpf(d.x); t.y = __builtin_amdgcn_rcpf(d.y);
    f32x2 q = t * 0.5307027145f + (-0.7265760135f); q = q * t + 0.7107068705f; q = q * t + (-0.142248368f); q = q * t + 0.127414796f; q = q * t;
    const f32x2 s = (v * v) * (-0.72134752044f);
    f32x2 e; e.x = __builtin_amdgcn_exp2f(s.x); e.y = __builtin_amdgcn_exp2f(s.y);
    const f32x2 m = v * (q * e), r = v - m;
    f32x2 o; o.x = v.x < 0.f ? m.x : r.x; o.y = v.y < 0.f ? m.y : r.y; return o;
}

template <int ACT  > struct EpiBf16 {
    static constexpr bool PERM = true, AFTER_DRAIN = false; static_assert(ACT == 0 || ACT == 1, "EpiBf16: ACT is 0 (none) or 1 (gelu_pk)");
    bf16_t* O; int ldc; const float* bias; int split_cols; size_t split_stride; float scale0;
    __device__ __forceinline__ void operator()(const f32x4 (&acc)[2][2][4][2], const Unit& u, int wr, int wc, int fr, int fq) const {
        const int row0 = u.pm * BM + wr * 64 + fr; int colt = u.pn * BM; bf16_t* base = O;
        float sc = 1.f; if (split_cols) { const int t = colt / split_cols; base += (size_t)t * split_stride; colt -= t * split_cols; if (t == 0) sc = scale0; }
        const int col0 = colt + wc * 32 + 8 * fq, bcol0 = u.pn * BM + wc * 32 + 8 * fq;
        f32x4 bv[2][2];
#pragma unroll
        for (int bj = 0; bj < 2; ++bj)
#pragma unroll
            for (int n = 0; n < 2; ++n) bv[bj][n] = bias ? *(const f32x4*)(bias + bcol0 + bj * HALF + 4 * n) : (f32x4){0.f, 0.f, 0.f, 0.f};
#pragma unroll
        for (int ai = 0; ai < 2; ++ai)
#pragma unroll
            for (int m = 0; m < 4; ++m) { bf16_t* rowp = base + (size_t)(row0 + ai * HALF + m * 16) * ldc + col0;
#pragma unroll
                for (int bj = 0; bj < 2; ++bj) { f32x4 v0 = acc[ai][bj][m][0] + bv[bj][0], v1 = acc[ai][bj][m][1] + bv[bj][1];
                    if (ACT == 1) { f32x2 a = gelu_pk((f32x2){v0[0], v0[1]}), b = gelu_pk((f32x2){v0[2], v0[3]}), c = gelu_pk((f32x2){v1[0], v1[1]}), d = gelu_pk((f32x2){v1[2], v1[3]});
                        v0 = (f32x4){a.x, a.y, b.x, b.y}; v1 = (f32x4){c.x, c.y, d.x, d.y}; }
                    v0 = v0 * sc; v1 = v1 * sc; u32x4 w; w.x = cvt_pk_bf16(v0[0], v0[1]); w.y = cvt_pk_bf16(v0[2], v0[3]); w.z = cvt_pk_bf16(v1[0], v1[1]); w.w = cvt_pk_bf16(v1[2], v1[3]);
                    *(u32x4*)(rowp + bj * HALF) = w; } }
    }
};

__device__ __forceinline__ float sigm(float x) { return __builtin_amdgcn_rcpf(1.0f + __builtin_amdgcn_exp2f(-1.4426950408889634f * x)); }
__device__ __forceinline__ float gelu_t(float x) { return x * sigm(x * (1.5957691216057308f + 0.07135481627260025f * x * x)); }
__device__ __forceinline__ u32x4 pack8(const float (&o)[8]) { u32x4 w; w.x = cvt_pk_bf16(o[0], o[1]); w.y = cvt_pk_bf16(o[2], o[3]); w.z = cvt_pk_bf16(o[4], o[5]); w.w = cvt_pk_bf16(o[6], o[7]); return w; }
constexpr float QSCALE = 0.125f * 1.4426950408889634f;

struct EpiIn {
    static constexpr bool PERM = true, AFTER_DRAIN = false;
    bf16_t *UG, *VS, *Q, *K, *VA, *GB; float* stats1; float* kmean; unsigned* khmax; PG8_LAS unsigned char* stage;
    __device__ __forceinline__ void operator()(const f32x4 (&acc)[2][2][4][2], const Unit& u, int wr, int wc, int fr, int fq) const {
        const int row0 = u.pm * BM + wr * 64 + fr, cw = wc * 32 + 8 * fq;
        if (u.pn < 8) {
            bf16_t* base = UG + (size_t)row0 * 1024 + u.pn * 128 + cw;
#pragma unroll
            for (int ai = 0; ai < 2; ++ai)
#pragma unroll
                for (int m = 0; m < 4; ++m) { float o[8];
#pragma unroll
                    for (int n = 0; n < 2; ++n)
#pragma unroll
                        for (int j = 0; j < 4; ++j) o[4 * n + j] = gelu_t(acc[ai][0][m][n][j]) * sigm(acc[ai][1][m][n][j]);
                    *(u32x4*)(base + (size_t)(ai * HALF + m * 16) * 1024) = pack8(o); }
            return;
        }
        const int kind = (u.pn - 8) >> 2, ct = (u.pn - 8) & 3;
        bf16_t* base = (kind == 0 ? VS : kind == 1 ? Q : kind == 2 ? K : kind == 3 ? VA : GB) + (size_t)row0 * 1024 + ct * 256 + cw;
        if (kind == 0) {
#pragma unroll
            for (int ai = 0; ai < 2; ++ai)
#pragma unroll
                for (int m = 0; m < 4; ++m) { float s1 = 0.f, s2 = 0.f;
#pragma unroll
                    for (int bj = 0; bj < 2; ++bj) { float o[8];
#pragma unroll
                        for (int n = 0; n < 2; ++n)
#pragma unroll
                            for (int j = 0; j < 4; ++j) { const float g = gelu_t(acc[ai][bj][m][n][j]); o[4 * n + j] = g; s1 += g; s2 += g * g; }
                        *(u32x4*)(base + (size_t)(ai * HALF + m * 16) * 1024 + bj * HALF) = pack8(o); }
                    s1 += __shfl_xor(s1, 16); s1 += __shfl_xor(s1, 32); s2 += __shfl_xor(s2, 16); s2 += __shfl_xor(s2, 32);
                    if (fq == 0) { float* sp = stats1 + 2 * (size_t)(row0 + ai * HALF + m * 16); atomicAdd(sp, s1); atomicAdd(sp + 1, s2); } }
        } else if (kind == 2) {
            float mx[2] = {0.f, 0.f};
            bf16_t* kfb = K + ((size_t)((u.pm >> 5) * 16 + 4 * ct + (wc >> 1)) * 65536 + (size_t)(u.pm & 31) * 2048 + wr * 512 + (2 * (wc & 1) + (fq >> 1)) * 64 + (fq & 1) * 32 + fr) * 8;
#pragma unroll
            for (int ai = 0; ai < 2; ++ai)
#pragma unroll
                for (int m = 0; m < 4; ++m)
#pragma unroll
                    for (int bj = 0; bj < 2; ++bj) { float o[8]; float ss = 0.f;
#pragma unroll
                        for (int n = 0; n < 2; ++n)
#pragma unroll
                            for (int j = 0; j < 4; ++j) { const float v = acc[ai][bj][m][n][j]; o[4 * n + j] = v; ss += v * v; }
                        *(u32x4*)(kfb + (size_t)bj * (2 * 65536 * 8) + (ai * 1024 + (m >> 1) * 256 + (m & 1) * 16) * 8) = pack8(o);
                        ss += __shfl_xor(ss, 16); ss += __shfl_xor(ss, 32); mx[bj] = fmaxf(mx[bj], ss); }
            float* km = kmean + (size_t)u.pm * 1024 + ct * 256 + cw;
#pragma unroll
            for (int bj = 0; bj < 2; ++bj)
#pragma unroll
                for (int n = 0; n < 2; ++n)
#pragma unroll
                    for (int j = 0; j < 4; ++j) { float cs = 0.f;
#pragma unroll
                        for (int ai = 0; ai < 2; ++ai)
#pragma unroll
                            for (int m = 0; m < 4; ++m) cs += acc[ai][bj][m][n][j];
                        cs += __shfl_xor(cs, 1); cs += __shfl_xor(cs, 2); cs += __shfl_xor(cs, 4); cs += __shfl_xor(cs, 8);
                        if (fr == 0) atomicAdd(km + bj * HALF + 4 * n + j, cs); }
#pragma unroll
            for (int bj = 0; bj < 2; ++bj) { float v = mx[bj];
                v = fmaxf(v, __shfl_xor(v, 1)); v = fmaxf(v, __shfl_xor(v, 2)); v = fmaxf(v, __shfl_xor(v, 4)); v = fmaxf(v, __shfl_xor(v, 8));
                if (fr == 0 && fq == 0) atomicMax(khmax + (u.pm >> 5) * 32 + ct * 8 + bj * 4 + wc, __float_as_uint(sqrtf(v))); }
        } else if (kind == 3) {
            PG8_LAS unsigned char* stg = stage + (wr * 4 + wc) * 2304; const int lane = fq * 16 + fr;
            bf16_t* vfb = VA + ((size_t)((u.pm >> 5) * 16 + 4 * ct + (wc >> 1)) * 65536 + (size_t)(u.pm & 31) * 2048 + (2 * (wc & 1)) * 512 + (2 * wr + ((lane & 7) >> 2)) * 64 + (lane & 3) * 16 + 8 * ((lane >> 5) & 1) + ((lane >> 3) & 3)) * 8;
#pragma unroll
            for (int ai = 0; ai < 2; ++ai)
#pragma unroll
                for (int bj = 0; bj < 2; ++bj)
#pragma unroll
                    for (int n = 0; n < 2; ++n) {
#pragma unroll
                        for (int m = 0; m < 4; ++m)
#pragma unroll
                            for (int j = 0; j < 4; ++j) { const float lo = acc[ai][bj][m][n][j]; *(PG8_LAS bf16_t*)(stg + (4 * fq + j) * 144 + (16 * m + fr) * 2) = (bf16_t)(cvt_pk_bf16(lo, lo) & 0xffffu); }
                        asm volatile("s_waitcnt lgkmcnt(0)" ::: "memory");
                        const int trow = u.pm * BM + ai * HALF + wr * 64; const int bb = trow >> 13, t0 = trow & 8191;
#pragma unroll
                        for (int i = 0; i < 2; ++i) { const int id = lane + 64 * i, col = id >> 3, ch = id & 7;
                            const u32x4 v = *(const PG8_LAS u32x4*)(stg + col * 144 + ch * 16);
                            *(u32x4*)(vfb + (size_t)bj * (2 * 65536 * 8) + (ai * 256 + n * 4 + i * 512) * 8) = v; }
                        asm volatile("s_waitcnt lgkmcnt(0)" ::: "memory"); }
        } else {
#pragma unroll
            for (int ai = 0; ai < 2; ++ai)
#pragma unroll
                for (int m = 0; m < 4; ++m)
#pragma unroll
                    for (int bj = 0; bj < 2; ++bj) { float o[8];
#pragma unroll
                        for (int n = 0; n < 2; ++n)
#pragma unroll
                            for (int j = 0; j < 4; ++j) { const float v = acc[ai][bj][m][n][j]; o[4 * n + j] = kind == 1 ? v * QSCALE : kind == 4 ? sigm(v) : v; }
                        *(u32x4*)(base + (size_t)(ai * HALF + m * 16) * 1024 + bj * HALF) = pack8(o); }
        }
    }
};
template <bool BASE_BF16> struct EpiResid {
    static constexpr bool PERM = true, AFTER_DRAIN = false;
    const void* base; bf16_t* outb; float* ss; bf16_t* outb2; int row2;
    static constexpr int NB = BASE_BF16 ? 1 : 2;
    __device__ __forceinline__ void ld(u32x4 (&d)[2][NB], size_t off) const {
#pragma unroll
        for (int bj = 0; bj < 2; ++bj) {
            if (BASE_BF16) d[bj][0] = *(const u32x4*)((const bf16_t*)base + off + bj * HALF);
            else { d[bj][0] = *(const u32x4*)((const float*)base + off + bj * HALF); d[bj][NB - 1] = *(const u32x4*)((const float*)base + off + bj * HALF + 4); } }
    }
    __device__ __forceinline__ void operator()(const f32x4 (&acc)[2][2][4][2], const Unit& u, int wr, int wc, int fr, int fq) const {
        const int row0 = u.pm * BM + wr * 64 + fr, col0 = u.pn * BM + wc * 32 + 8 * fq;
        u32x4 pre[4][2][NB];
#pragma unroll
        for (int m = 0; m < 4; ++m) ld(pre[m], (size_t)(row0 + m * 16) * 1024 + col0);
#pragma unroll
        for (int ai = 0; ai < 2; ++ai)
#pragma unroll
            for (int m = 0; m < 4; ++m) { const int row = row0 + ai * HALF + m * 16; const size_t off = (size_t)row * 1024 + col0; float s = 0.f;
                u32x4 cur[2][NB];
#pragma unroll
                for (int bj = 0; bj < 2; ++bj)
#pragma unroll
                    for (int q = 0; q < NB; ++q) cur[bj][q] = pre[m][bj][q];
                if (ai == 0) ld(pre[m], off + (size_t)HALF * 1024);
#pragma unroll
                for (int bj = 0; bj < 2; ++bj) { f32x4 b0, b1;
                    if (BASE_BF16) { const u32x4 w = cur[bj][0];
                        b0 = (f32x4){__uint_as_float(w.x << 16), __uint_as_float(w.x & 0xffff0000u), __uint_as_float(w.y << 16), __uint_as_float(w.y & 0xffff0000u)};
                        b1 = (f32x4){__uint_as_float(w.z << 16), __uint_as_float(w.z & 0xffff0000u), __uint_as_float(w.w << 16), __uint_as_float(w.w & 0xffff0000u)}; }
                    else { b0 = __builtin_bit_cast(f32x4, cur[bj][0]); b1 = __builtin_bit_cast(f32x4, cur[bj][NB - 1]); }
                    const f32x4 v0 = acc[ai][bj][m][0] + b0, v1 = acc[ai][bj][m][1] + b1;
                    const float o[8] = {v0[0], v0[1], v0[2], v0[3], v1[0], v1[1], v1[2], v1[3]};
                    *(u32x4*)((row < row2 ? outb : outb2 - (size_t)row2 * 1024) + off + bj * HALF) = pack8(o);
#pragma unroll
                    for (int j = 0; j < 8; ++j) s += o[j] * o[j]; }
                s += __shfl_xor(s, 16); s += __shfl_xor(s, 32);
                if (fq == 0) atomicAdd(ss + row, s); }
    }
};
struct EpiFF1 {
    static constexpr bool PERM = true, AFTER_DRAIN = false;
    bf16_t* O; const float* ss; float eps;
    __device__ __forceinline__ void operator()(const f32x4 (&acc)[2][2][4][2], const Unit& u, int wr, int wc, int fr, int fq) const {
        const int row0 = u.pm * BM + wr * 64 + fr, col0 = u.pn * BM + wc * 32 + 8 * fq;
        float ssv[2][4];
#pragma unroll
        for (int ai = 0; ai < 2; ++ai)
#pragma unroll
            for (int m = 0; m < 4; ++m) ssv[ai][m] = ss[row0 + ai * HALF + m * 16];
#pragma unroll
        for (int ai = 0; ai < 2; ++ai)
#pragma unroll
            for (int m = 0; m < 4; ++m) { const int row = row0 + ai * HALF + m * 16; const float rs = 1.0f / sqrtf(ssv[ai][m] * (1.0f / 1024.0f) + eps);
#pragma unroll
                for (int bj = 0; bj < 2; ++bj) { float o[8];
#pragma unroll
                    for (int n = 0; n < 2; ++n)
#pragma unroll
                        for (int j = 0; j < 4; ++j) { const float v = fmaxf(acc[ai][bj][m][n][j] * rs, 0.f); o[4 * n + j] = v * v; }
                    *(u32x4*)(O + (size_t)row * 4096 + col0 + bj * HALF) = pack8(o); } }
    }
};
struct EpiStore {
    static constexpr bool PERM = true, AFTER_DRAIN = false;
    bf16_t* O_; bf16_t* O2; int row2;
    __device__ __forceinline__ void operator()(const f32x4 (&acc)[2][2][4][2], const Unit& u, int wr, int wc, int fr, int fq) const {
        const int row0 = u.pm * BM + wr * 64 + fr, col0 = u.pn * BM + wc * 32 + 8 * fq;
        bf16_t* O = u.pm * BM < row2 ? O_ : O2 - (size_t)row2 * 1024;
#pragma unroll
        for (int ai = 0; ai < 2; ++ai)
#pragma unroll
            for (int m = 0; m < 4; ++m)
#pragma unroll
                for (int bj = 0; bj < 2; ++bj) { float o[8];
#pragma unroll
                    for (int n = 0; n < 2; ++n)
#pragma unroll
                        for (int j = 0; j < 4; ++j) o[4 * n + j] = acc[ai][bj][m][n][j];
                    *(u32x4*)(O + (size_t)(row0 + ai * HALF + m * 16) * 1024 + col0 + bj * HALF) = pack8(o); }
    }
};
struct EpiPle {
    static constexpr bool PERM = true, AFTER_DRAIN = false;
    const bf16_t* X; const bf16_t* X2; int row2; const bf16_t* PP_; const bf16_t* PP2; int prow2; const float* ssin; float* ssout; float eps; unsigned* pcnt; const float* gf; float* out;
    __device__ __forceinline__ void operator()(const f32x4 (&acc_)[2][2][4][2], const Unit& u, int wr, int wc, int fr, int fq) const {
        f32x4 (&acc)[2][2][4][2] = const_cast<f32x4 (&)[2][2][4][2]>(acc_);
        const int row0 = u.pm * BM + wr * 64 + fr, col0 = u.pn * BM + wc * 32 + 8 * fq;
        const bf16_t* PP = u.pm * BM < prow2 ? PP_ : PP2 - (size_t)prow2 * 1024;
        constexpr int PD = 3;
        float ssv[2][4]; u32x4 xq[PD][2], pq[PD][2];
#pragma unroll
        for (int ai = 0; ai < 2; ++ai)
#pragma unroll
            for (int m = 0; m < 4; ++m) ssv[ai][m] = ssin[row0 + ai * HALF + m * 16];
#define PLE_LD(slot, it_) do { const int rn_ = row0 + ((it_) >> 2) * HALF + ((it_) & 3) * 16; const size_t offn_ = (size_t)rn_ * 1024 + col0; \
            _Pragma("unroll") for (int bj = 0; bj < 2; ++bj) { xq[slot][bj] = *(const u32x4*)((rn_ < row2 ? X : X2 - (size_t)row2 * 1024) + offn_ + bj * HALF); pq[slot][bj] = *(const u32x4*)(PP + offn_ + bj * HALF); } } while (0)
#pragma unroll
        for (int it = 0; it < PD; ++it) PLE_LD(it, it);
#pragma unroll
        for (int it = 0; it < 8; ++it) { const int ai = it >> 2, m = it & 3; const int row = row0 + ai * HALF + m * 16; const float rs = 1.0f / sqrtf(ssv[ai][m] * (1.0f / 1024.0f) + eps); float s = 0.f;
                u32x4 xc[2], pc[2];
#pragma unroll
                for (int bj = 0; bj < 2; ++bj) { xc[bj] = xq[it % PD][bj]; pc[bj] = pq[it % PD][bj]; }
                if (it + PD < 8) PLE_LD(it % PD, it + PD);
#pragma unroll
                for (int bj = 0; bj < 2; ++bj) { const u32x4 xw = xc[bj];
                    const f32x4 b0 = {__uint_as_float(xw.x << 16), __uint_as_float(xw.x & 0xffff0000u), __uint_as_float(xw.y << 16), __uint_as_float(xw.y & 0xffff0000u)};
                    const f32x4 b1 = {__uint_as_float(xw.z << 16), __uint_as_float(xw.z & 0xffff0000u), __uint_as_float(xw.w << 16), __uint_as_float(xw.w & 0xffff0000u)};
                    const u32x4 pw = pc[bj];
                    const float pp[8] = {__uint_as_float(pw.x << 16), __uint_as_float(pw.x & 0xffff0000u), __uint_as_float(pw.y << 16), __uint_as_float(pw.y & 0xffff0000u),
                                         __uint_as_float(pw.z << 16), __uint_as_float(pw.z & 0xffff0000u), __uint_as_float(pw.w << 16), __uint_as_float(pw.w & 0xffff0000u)};
                    f32x4 v0, v1;
#pragma unroll
                    for (int j = 0; j < 4; ++j) { v0[j] = b0[j] + sigm(acc[ai][bj][m][0][j] * rs) * pp[j]; v1[j] = b1[j] + sigm(acc[ai][bj][m][1][j] * rs) * pp[4 + j]; }
                    acc[ai][bj][m][0] = v0; acc[ai][bj][m][1] = v1;
#pragma unroll
                    for (int j = 0; j < 4; ++j) s += v0[j] * v0[j] + v1[j] * v1[j]; }
                s += __shfl_xor(s, 16); s += __shfl_xor(s, 32);
                if (fq == 0) atomicAdd(ssout + row, s); }
#undef PLE_LD
        asm volatile("s_waitcnt vmcnt(0)" ::: "memory"); __syncthreads();
        if (threadIdx.x == 0) { unsigned* c = pcnt + 64 * u.pm; __hip_atomic_fetch_add(c, 1u, __ATOMIC_RELAXED, __HIP_MEMORY_SCOPE_AGENT);
            unsigned sp = 0; while (__hip_atomic_load(c, __ATOMIC_RELAXED, __HIP_MEMORY_SCOPE_AGENT) < 4u) { __builtin_amdgcn_s_sleep(1); if (++sp > (1u << 22)) break; } }
        __syncthreads();
        float so[2][4]; f32x4 gq[2][2];
#pragma unroll
        for (int ai = 0; ai < 2; ++ai)
#pragma unroll
            for (int m = 0; m < 4; ++m) so[ai][m] = __hip_atomic_load(ssout + row0 + ai * HALF + m * 16, __ATOMIC_RELAXED, __HIP_MEMORY_SCOPE_AGENT);
#pragma unroll
        for (int bj = 0; bj < 2; ++bj) { gq[bj][0] = *(const f32x4*)(gf + col0 + bj * HALF); gq[bj][1] = *(const f32x4*)(gf + col0 + bj * HALF + 4); }
#pragma unroll
        for (int ai = 0; ai < 2; ++ai)
#pragma unroll
            for (int m = 0; m < 4; ++m) { const int row = row0 + ai * HALF + m * 16; const size_t off = (size_t)row * 1024 + col0;
                const float rs = 1.0f / sqrtf(so[ai][m] * (1.0f / 1024.0f) + eps);
#pragma unroll
                for (int bj = 0; bj < 2; ++bj) { *(f32x4*)(out + off + bj * HALF) = acc[ai][bj][m][0] * rs * gq[bj][0]; *(f32x4*)(out + off + bj * HALF + 4) = acc[ai][bj][m][1] * rs * gq[bj][1]; } }
    }
};

template <class Epi, class Sched, bool ALIGN_EPI = false, bool SP2 = false>
__device__ __forceinline__ void gemm_phase(PG8_LAS unsigned char* lds, const Gemm g, const Sched& S, const Epi& E) {
    int tid_ = threadIdx.x; asm volatile("" : "+v"(tid_));
    const int tid = tid_, wid = __builtin_amdgcn_readfirstlane(tid >> 6), lane = tid & 63, wr = wid >> 2, wc = wid & 3, fr = lane & 15, fq = lane >> 4;
    const int K = g.K, nt = K / BK;
    unsigned voffA[2], voffB[2];
#pragma unroll
    for (int i = 0; i < 2; ++i) { int R, C; stage_rc(tid * 16 + i * 8192, R, C); const int Rb = Epi::PERM ? ((R & ~31) + perm32(R & 31)) : R;
        voffA[i] = (unsigned)(R * K + C) * 2u; voffB[i] = (unsigned)(Rb * K + C) * 2u; }
    const size_t kstep = (size_t)(BK * 2);
    const size_t hstep = (size_t)HALF * K * 2;
    const size_t tstep = 2 * hstep;
    const unsigned ldsw = (unsigned)wid * 1024u;
    const int aoff = lds_byte(wr * 64 + fr, fq * 8), boff = lds_byte(wc * 32 + fr, fq * 8);
#define PG8_ABASE(pm_) ((pm_) < g.pm2 ? (const char*)g.A + (size_t)(pm_) * tstep : (const char*)g.A2 + (size_t)((pm_) - g.pm2) * tstep)
#define PG8_SA(b, h) (((b) * 2 + (h)) * HTB)
#define PG8_SB(b, h) ((4 + (b) * 2 + (h)) * HTB)
#define PG8_STAGE(bufoff, gbase, voff) do { _Pragma("unroll") for (int _i = 0; _i < 2; ++_i) \
        __builtin_amdgcn_global_load_lds((const unsigned*)((const char*)(gbase) + (voff)[_i]), (PG8_LAS unsigned*)(lds + (bufoff) + ldsw + _i * 8192), 16, 0, 0); } while (0)
#define PG8_LDA(dst, b, h) do { _Pragma("unroll") for (int m = 0; m < 4; ++m) _Pragma("unroll") for (int k = 0; k < 2; ++k) dst[m][k] = *(const PG8_LAS bf16x8*)(lds + PG8_SA(b, h) + aoff + m * 2048 + k * 1024); } while (0)
#define PG8_LDB(dst, b, h) do { _Pragma("unroll") for (int n = 0; n < 2; ++n) _Pragma("unroll") for (int k = 0; k < 2; ++k) dst[n][k] = *(const PG8_LAS bf16x8*)(lds + PG8_SB(b, h) + boff + n * 2048 + k * 1024); } while (0)
#define PG8_MMA(ai, bj, At, Bt) do { __builtin_amdgcn_s_setprio(1); _Pragma("unroll") for (int m = 0; m < 4; ++m) _Pragma("unroll") for (int n = 0; n < 2; ++n) _Pragma("unroll") for (int k = 0; k < 2; ++k) \
        acc[ai][bj][m][n] = __builtin_amdgcn_mfma_f32_16x16x32_bf16(Bt[n][k], At[m][k], acc[ai][bj][m][n], 0, 0, 0); __builtin_amdgcn_s_setprio(0); } while (0)
#define PG8_WAIT_V(n) asm volatile("s_waitcnt vmcnt(" #n ")" ::: "memory")
#define PG8_WAIT_L(n) asm volatile("s_waitcnt lgkmcnt(" #n ")" ::: "memory")
#define PG8_BAR __builtin_amdgcn_s_barrier()
#define PG8_SCHED __builtin_amdgcn_sched_barrier(0)
    Unit cur, nxt; int ui = 0;
    if (!S.next(0, cur)) return;
    f32x4 acc[2][2][4][2];
#pragma unroll
    for (int a = 0; a < 2; ++a)
#pragma unroll
        for (int b = 0; b < 2; ++b)
#pragma unroll
            for (int m = 0; m < 4; ++m)
#pragma unroll
                for (int n = 0; n < 2; ++n) acc[a][b][m][n] = (f32x4){0.f, 0.f, 0.f, 0.f};
    bf16x8 At[4][2], B0[2][2], B1[2][2];
    const char* cA = PG8_ABASE(cur.pm); const char* cB = (const char*)g.Bt + (size_t)cur.pn * tstep;
    S.a_ready(cur);
    if constexpr (SP2) {
        PG8_STAGE(PG8_SB(0, 0), cB, voffB); PG8_STAGE(PG8_SB(0, 1), cB + hstep, voffB); PG8_STAGE(PG8_SA(0, 0), cA, voffA); PG8_STAGE(PG8_SA(0, 1), cA + hstep, voffA);
        if (wr == 1) PG8_BAR;
        PG8_WAIT_V(2); PG8_BAR;
        PG8_STAGE(PG8_SB(1, 0), cB + kstep, voffB); PG8_STAGE(PG8_SA(1, 0), cA + kstep, voffA); PG8_STAGE(PG8_SB(1, 1), cB + hstep + kstep, voffB);
        PG8_WAIT_V(6); PG8_BAR;
    } else {
        PG8_STAGE(PG8_SB(0, 0), cB, voffB); PG8_STAGE(PG8_SA(0, 0), cA, voffA); PG8_STAGE(PG8_SB(0, 1), cB + hstep, voffB); PG8_STAGE(PG8_SA(0, 1), cA + hstep, voffA);
        if (wr == 1) PG8_BAR;
        PG8_WAIT_V(4); PG8_BAR;
        PG8_STAGE(PG8_SB(1, 0), cB + kstep, voffB); PG8_STAGE(PG8_SA(1, 0), cA + kstep, voffA); PG8_STAGE(PG8_SB(1, 1), cB + hstep + kstep, voffB);
        PG8_WAIT_V(6); PG8_BAR;
    }
    for (;;) {
        const bool has_next = S.next(ui + 1, nxt);
        const char* nA = has_next ? PG8_ABASE(nxt.pm) : cA; const char* nB = has_next ? (const char*)g.Bt + (size_t)nxt.pn * tstep : cB;
        for (int t = 0; t < nt; t += 2) {
            const bool last = (t == nt - 2);
            const char* a1 = cA + (size_t)(t + 1) * kstep;
            const char* a2 = last ? nA : cA + (size_t)(t + 2) * kstep; const char* b2 = last ? nB : cB + (size_t)(t + 2) * kstep;
            const char* a3 = a2 + kstep; const char* b3 = b2 + kstep;
            if (last && has_next) S.a_ready(nxt);
            if constexpr (SP2) {
            PG8_LDB(B0, 0, 0); PG8_LDB(B1, 0, 1); PG8_SCHED; PG8_LDA(At, 0, 0); PG8_STAGE(PG8_SA(1, 1), a1 + hstep, voffA);
            PG8_WAIT_V(8); PG8_WAIT_L(0); PG8_BAR; PG8_MMA(0, 0, At, B0); PG8_MMA(0, 1, At, B1); PG8_BAR; PG8_SCHED;
            PG8_LDA(At, 0, 1); PG8_STAGE(PG8_SB(0, 0), b2, voffB); PG8_STAGE(PG8_SB(0, 1), b2 + hstep, voffB); PG8_STAGE(PG8_SA(0, 0), a2, voffA);
            PG8_WAIT_V(8); PG8_WAIT_L(0); PG8_BAR; PG8_MMA(1, 0, At, B0); PG8_MMA(1, 1, At, B1); PG8_BAR; PG8_SCHED;
            PG8_LDB(B0, 1, 0); PG8_LDB(B1, 1, 1); PG8_SCHED; PG8_LDA(At, 1, 0); PG8_STAGE(PG8_SA(0, 1), a2 + hstep, voffA);
            PG8_WAIT_V(8); PG8_WAIT_L(0); PG8_BAR; PG8_MMA(0, 0, At, B0); PG8_MMA(0, 1, At, B1); PG8_BAR; PG8_SCHED;
            PG8_LDA(At, 1, 1); PG8_STAGE(PG8_SB(1, 0), b3, voffB); PG8_STAGE(PG8_SB(1, 1), b3 + hstep, voffB); PG8_STAGE(PG8_SA(1, 0), a3, voffA);
            PG8_WAIT_V(8); PG8_WAIT_L(0); PG8_BAR; PG8_MMA(1, 0, At, B0); PG8_MMA(1, 1, At, B1); PG8_BAR; PG8_SCHED;
            } else {
            PG8_LDB(B0, 0, 0); PG8_SCHED; PG8_LDA(At, 0, 0); PG8_STAGE(PG8_SA(1, 1), a1 + hstep, voffA);
            PG8_WAIT_L(8); PG8_BAR; PG8_WAIT_L(0); PG8_MMA(0, 0, At, B0); PG8_BAR; PG8_SCHED;
            PG8_LDB(B1, 0, 1); PG8_STAGE(PG8_SB(0, 0), b2, voffB);
            PG8_BAR; PG8_WAIT_L(0); PG8_MMA(0, 1, At, B1); PG8_BAR;
            PG8_LDA(At, 0, 1); PG8_STAGE(PG8_SA(0, 0), a2, voffA);
            PG8_BAR; PG8_WAIT_L(0); PG8_MMA(1, 0, At, B0); PG8_BAR; PG8_SCHED;
            PG8_STAGE(PG8_SB(0, 1), b2 + hstep, voffB);
            PG8_WAIT_V(6); PG8_BAR; PG8_MMA(1, 1, At, B1); PG8_BAR;
            PG8_LDB(B0, 1, 0); PG8_SCHED; PG8_LDA(At, 1, 0); PG8_STAGE(PG8_SA(0, 1), a2 + hstep, voffA);
            PG8_WAIT_L(8); PG8_BAR; PG8_WAIT_L(0); PG8_MMA(0, 0, At, B0); PG8_BAR; PG8_SCHED;
            PG8_LDB(B1, 1, 1); PG8_STAGE(PG8_SB(1, 0), b3, voffB);
            PG8_BAR; PG8_WAIT_L(0); PG8_MMA(0, 1, At, B1); PG8_BAR;
            PG8_LDA(At, 1, 1); PG8_STAGE(PG8_SA(1, 0), a3, voffA);
            PG8_BAR; PG8_WAIT_L(0); PG8_MMA(1, 0, At, B0); PG8_BAR; PG8_SCHED;
            PG8_STAGE(PG8_SB(1, 1), b3 + hstep, voffB);
            PG8_WAIT_V(6); PG8_BAR; PG8_MMA(1, 1, At, B1); PG8_BAR;
            }
        }
        if constexpr (ALIGN_EPI) { if (wr == 0) PG8_BAR; }
        if constexpr (!Epi::AFTER_DRAIN) { E(acc, cur, wr, wc, fr, fq); S.done(cur); }
        if (!has_next) break;
#pragma unroll
        for (int a = 0; a < 2; ++a)
#pragma unroll
            for (int b = 0; b < 2; ++b)
#pragma unroll
                for (int m = 0; m < 4; ++m)
#pragma unroll
                    for (int n = 0; n < 2; ++n) acc[a][b][m][n] = (f32x4){0.f, 0.f, 0.f, 0.f};
        cur = nxt; cA = nA; cB = nB; ++ui;
        if constexpr (ALIGN_EPI) { if (wr == 1) PG8_BAR; }
    }
    PG8_WAIT_V(0);
    if constexpr (!ALIGN_EPI) { if (wr == 0) PG8_BAR; }
    PG8_BAR;
    if constexpr (Epi::AFTER_DRAIN) { E.fused(acc, cur, wr, wc, fr, fq, lds, wid, lane); S.done(cur); }
#undef PG8_ABASE
#undef PG8_SA
#undef PG8_SB
#undef PG8_STAGE
#undef PG8_LDA
#undef PG8_LDB
#undef PG8_MMA
#undef PG8_WAIT_V
#undef PG8_WAIT_L
#undef PG8_BAR
#undef PG8_SCHED
}
}
#define GAS __attribute__((address_space(1)))
#define LAS __attribute__((address_space(3)))
typedef unsigned short bf16;
typedef unsigned v4u __attribute__((ext_vector_type(4)));
typedef float f32x4 __attribute__((ext_vector_type(4)));
typedef short bf16x8 __attribute__((ext_vector_type(8)));
typedef GAS unsigned gu32;
typedef GAS unsigned long long gu64;
#define RLX_AGENT __ATOMIC_RELAXED, __HIP_MEMORY_SCOPE_AGENT
#define LDS_WAIT() asm volatile("s_waitcnt lgkmcnt(0)" ::: "memory")
#define VM_WAIT() asm volatile("s_waitcnt vmcnt(0)" ::: "memory")
__device__ __forceinline__ unsigned long long rt() { return __builtin_amdgcn_s_memrealtime(); }
__device__ __forceinline__ unsigned f2bf(float f) { unsigned u = __builtin_bit_cast(unsigned, f); return (u + 0x7fffu + ((u >> 16) & 1u)) >> 16; }
__device__ __forceinline__ unsigned pk2(float lo, float hi) { return f2bf(lo) | (f2bf(hi) << 16); }

#define XB_TMO      128
#define XB_XCNT(j)  (256  + 64 * (j))
#define XB_XSUB(j)  (1280 + 64 * (j))
#define XB_XGEN(j)  (2304 + 64 * (j))
#define XB_TOP      3328
#define XB_TOPGEN   3392
#define XCD_BAR_WORDS 3456
#define XB_GSUB(j)  (3520 + 64 * (j))
#define XB_GGEN(j)  (4096 + 64 * (j))
#define XB_XID      4672
#define XB_QSUB(q)  (8192 + 64 * (q))
#define XB_QGEN(q)  (12288 + 64 * (q))
#define XB_SPIN_CAP (1u << 22)

__device__ __forceinline__ unsigned xb_ld(unsigned* p)              { return __hip_atomic_load(p, __ATOMIC_RELAXED, __HIP_MEMORY_SCOPE_AGENT); }
__device__ __forceinline__ unsigned xb_add(unsigned* p, unsigned v) { return __hip_atomic_fetch_add(p, v, __ATOMIC_RELAXED, __HIP_MEMORY_SCOPE_AGENT); }
__device__ __forceinline__ unsigned xb_xcc_id() { return (unsigned)__builtin_amdgcn_s_getreg((3 << 11) | 20) & 0xFu; }
#define XB_SPIN(cond, bar) do { unsigned _sp = 0; while (cond) { __builtin_amdgcn_s_sleep(1); \
    if ((++_sp & 255u) == 0u) { if (xb_ld(&(bar)[XB_TMO])) break; if (_sp > XB_SPIN_CAP) { atomicAdd(&(bar)[XB_TMO], 1u); break; } } } } while (0)

struct XcdBarrier {
    unsigned* bar; unsigned x;
    volatile LAS unsigned* st;
};

__device__ __forceinline__ XcdBarrier xcd_barrier_post(unsigned* bar, volatile LAS unsigned* st) {
    XcdBarrier b; b.bar = bar; b.x = xb_xcc_id(); b.st = st;
    if (threadIdx.x == 0) { (void)xb_add(&bar[XB_XCNT(b.x)], 1u); if (blockIdx.x < 256) __hip_atomic_store(&bar[XB_XID + blockIdx.x], b.x + 1u, __ATOMIC_RELAXED, __HIP_MEMORY_SCOPE_AGENT); }
    return b;
}
__device__ __forceinline__ void xcd_barrier_complete(unsigned* bar, unsigned x, unsigned& nloc, unsigned& nx) {
    const unsigned G = gridDim.x * gridDim.y * gridDim.z;
    unsigned sum, cnt, mine, sp = 0u;
    for (;;) {
        sum = 0u; cnt = 0u; mine = 0u;
#pragma unroll
        for (unsigned j = 0; j < 16; ++j) { const unsigned c = xb_ld(&bar[XB_XCNT(j)]); sum += c; cnt += (c > 0u) ? 1u : 0u; mine = (j == x) ? c : mine; }
        if (sum == G) break;
        __builtin_amdgcn_s_sleep(1);
        if ((++sp & 255u) == 0u) { if (xb_ld(&bar[XB_TMO])) break; if (sp > XB_SPIN_CAP) { atomicAdd(&bar[XB_TMO], 1u); break; } }
    }
    nloc = mine > 0u ? mine : 1u; nx = cnt > 0u ? cnt : 1u;
}

__device__ __forceinline__ void xcd_barrier(const XcdBarrier& b) {
    asm volatile("s_waitcnt vmcnt(0)" ::: "memory");
    __syncthreads();
    if (threadIdx.x == 0) {
        unsigned* bar = b.bar;
        __builtin_amdgcn_s_waitcnt(0);
        unsigned nloc = b.st[0], nx = b.st[1];
        if (nloc == 0u) { xcd_barrier_complete(bar, b.x, nloc, nx); b.st[0] = nloc; b.st[1] = nx; }
        const unsigned old = xb_add(&bar[XB_XSUB(b.x)], 1u);
        const unsigned gen = old / nloc;
        if (old + 1u == (gen + 1u) * nloc) {
            __builtin_amdgcn_fence(__ATOMIC_RELEASE, "agent");
            asm volatile("s_waitcnt vmcnt(0)" ::: "memory");
            const unsigned og = xb_add(&bar[XB_TOP], 1u);
            const unsigned tg = og / nx;
            if (og + 1u == (tg + 1u) * nx) xb_add(&bar[XB_TOPGEN], 1u);
            else XB_SPIN(xb_ld(&bar[XB_TOPGEN]) == tg, bar);
            __builtin_amdgcn_fence(__ATOMIC_ACQUIRE, "agent");
            xb_add(&bar[XB_XGEN(b.x)], 1u);
            asm volatile("s_waitcnt vmcnt(0)" ::: "memory");
        } else {
            XB_SPIN(xb_ld(&bar[XB_XGEN(b.x)]) == gen, bar);
            __builtin_amdgcn_fence(__ATOMIC_ACQUIRE, "agent");
            asm volatile("s_waitcnt vmcnt(0)" ::: "memory");
        }
    }
    __syncthreads();
}

__device__ __forceinline__ bool grp_local_ok(const XcdBarrier& b, volatile LAS unsigned* flag) {
    if (threadIdx.x == 0) *flag = 1u;
    __syncthreads();
    if (gridDim.x != 256) { if (threadIdx.x == 0) *flag = 0u; }
    else if (threadIdx.x < 256) { const unsigned mine = xb_ld(&b.bar[XB_XID + threadIdx.x]), first = xb_ld(&b.bar[XB_XID + (threadIdx.x & 7)]); if (mine != first || mine == 0u) *flag = 0u; }
    __syncthreads();
    return *flag != 0u;
}
__device__ __forceinline__ void quad_barrier(const XcdBarrier& b, unsigned q) {
    asm volatile("s_waitcnt vmcnt(0)" ::: "memory");
    __syncthreads();
    if (threadIdx.x == 0) {
        unsigned* bar = b.bar;
        const unsigned old = xb_add(&bar[XB_QSUB(q)], 1u), gen = old / 4u;
        if (old + 1u == (gen + 1u) * 4u) xb_add(&bar[XB_QGEN(q)], 1u);
        else XB_SPIN(xb_ld(&bar[XB_QGEN(q)]) == gen, bar);
        __builtin_amdgcn_fence(__ATOMIC_ACQUIRE, "agent");
        asm volatile("s_waitcnt vmcnt(0)" ::: "memory");
    }
    __syncthreads();
}
__device__ __forceinline__ void grp_barrier(const XcdBarrier& b, unsigned g) {
    asm volatile("s_waitcnt vmcnt(0)" ::: "memory");
    __syncthreads();
    if (threadIdx.x == 0) {
        unsigned* bar = b.bar;
        const unsigned old = xb_add(&bar[XB_GSUB(g)], 1u), gen = old / 32u;
        if (old + 1u == (gen + 1u) * 32u) xb_add(&bar[XB_GGEN(g)], 1u);
        else XB_SPIN(xb_ld(&bar[XB_GGEN(g)]) == gen, bar);
        __builtin_amdgcn_fence(__ATOMIC_ACQUIRE, "agent");
        asm volatile("s_waitcnt vmcnt(0)" ::: "memory");
    }
    __syncthreads();
}

constexpr int NWAVES = 8;
constexpr int BATCH = 2, SEQ = 8192, D = 1024, H = 16, HD = 64, FF = 4096, PLE = 256, NIN = 7168;
constexpr int M = BATCH * SEQ;
constexpr float EPS = 1e-6f;
constexpr float LOG2E = 1.4426950408889634f;

constexpr size_t MiB = 1u << 20, KiB = 1u << 10;
constexpr size_t WS_CTL = 0, CTL_ZERO_BYTES = 1 * MiB;
constexpr size_t CT_STATS1 = 0;
constexpr size_t CT_SS2 = 128 * KiB, CT_SS3 = 192 * KiB, CT_SS4 = 256 * KiB;
constexpr size_t CT_KMEAN = 320 * KiB;
constexpr size_t CT_KHMAX = 576 * KiB;
constexpr size_t CT_PCNT = 600 * KiB;
constexpr size_t CT_BAR = 640 * KiB;
constexpr size_t WS_WIN = 1 * MiB, WS_WOUT = 15 * MiB, WS_W1 = 17 * MiB, WS_W2 = 25 * MiB, WS_WG = 33 * MiB, WS_WP = 35 * MiB;
constexpr size_t WS_WM = 35 * MiB + 512 * KiB, WS_LUT = 35 * MiB + 768 * KiB;
constexpr size_t WS_Q = 36 * MiB, WS_K = 68 * MiB, WS_UG = 100 * MiB, WS_VS = 132 * MiB, WS_VA = 164 * MiB, WS_GB = 196 * MiB, WS_PB = 228 * MiB;
constexpr size_t WS_X1 = 36 * MiB;
constexpr size_t WS_A = 100 * MiB;
constexpr size_t WS_X2B_LO = 36 * MiB, WS_X2B_HI = 52 * MiB;
constexpr size_t WS_PP_LO = 1 * MiB, WS_PP_HI = 236 * MiB; constexpr int PP_ROW2 = 7168;
constexpr size_t CT_DONE3 = 624 * KiB;
constexpr size_t WS_END = 256 * MiB;

constexpr int RING_OFF = 0, RING_BYTES = 131072;
constexpr int LDSCTL_OFF = 156816, MISC_OFF = LDSCTL_OFF + 320;
constexpr int LDS_BYTES = 159744;

struct Frame {
    LAS unsigned char* lds;
    volatile LAS unsigned* MISC;
    unsigned char* ws;
    int tid, lane, wave, vcu, G;
    const float* in[17];
    float* out;
};

__device__ __forceinline__ float wave_sum(float v) {
#pragma unroll
    for (int o = 1; o < 64; o <<= 1) v += __shfl_xor(v, o);
    return v;
}
__device__ __forceinline__ float wave_max(float v) {
#pragma unroll
    for (int o = 1; o < 64; o <<= 1) v = fmaxf(v, __shfl_xor(v, o));
    return v;
}
__device__ __forceinline__ int wave_min_i(int v) {
#pragma unroll
    for (int o = 1; o < 64; o <<= 1) { const int t = __shfl_xor(v, o); v = t < v ? t : v; }
    return v;
}
__device__ __forceinline__ float bflo(unsigned w) { return __uint_as_float(w << 16); }
__device__ __forceinline__ float bfhi(unsigned w) { return __uint_as_float(w & 0xffff0000u); }

__device__ __forceinline__ int win_rowmap(int c) {
    if (c < 1024) return (c >> 7) * 256 + (c & 127);
    if (c < 5120) return c + 1024;
    if (c < 6144) { const int d = c - 5120; return (d >> 7) * 256 + 128 + (d & 127); }
    return c;
}
__device__ __forceinline__ void p0_transpose_item(const float* W, int K, int N, bf16* WT, int dst_row0, int k0, int n0, const float* gk, LAS float* scr, int lane) {
#pragma unroll 8
    for (int i = 0; i < 32; ++i) { const int kk = 2 * i + (lane >> 5); scr[kk * 33 + (lane & 31)] = W[(size_t)(k0 + kk) * N + n0 + (lane & 31)]; }
    LDS_WAIT(); asm volatile("" ::: "memory");
    const int c = lane & 7;
    float g[8];
#pragma unroll
    for (int e = 0; e < 8; ++e) g[e] = gk ? gk[k0 + 8 * c + e] : 1.0f;
#pragma unroll
    for (int j = 0; j < 4; ++j) { const int n = (lane >> 3) + 8 * j; const LAS float* s = scr + (8 * c) * 33 + n;
        v4u o; o.x = pk2(s[0 * 33] * g[0], s[1 * 33] * g[1]); o.y = pk2(s[2 * 33] * g[2], s[3 * 33] * g[3]); o.z = pk2(s[4 * 33] * g[4], s[5 * 33] * g[5]); o.w = pk2(s[6 * 33] * g[6], s[7 * 33] * g[7]);
        *(GAS v4u*)(WT + (size_t)(dst_row0 + n) * K + k0 + 8 * c) = o; }
    LDS_WAIT(); asm volatile("" ::: "memory");
}
__device__ __forceinline__ int rel_bucket(int n) {
    if (n < 16) return n;
    int b = 16;
    b += (n >= 21); b += (n >= 27); b += (n >= 35); b += (n >= 46); b += (n >= 59); b += (n >= 77); b += (n >= 99); b += (n >= 128);
    b += (n >= 166); b += (n >= 216); b += (n >= 280); b += (n >= 363); b += (n >= 470); b += (n >= 609); b += (n >= 790);
    return b;
}
__device__ __forceinline__ void p0_prologue(Frame& F, const int part) {
    LAS float* scr = (LAS float*)(F.lds + RING_OFF + F.wave * 16384);
    const int gw = F.vcu * NWAVES + F.wave, NGW = F.G * NWAVES;
    const float *x = F.in[0], *p = F.in[1], *g_mix = F.in[2], *w_in = F.in[3], *w_s = F.in[4], *rel = F.in[8], *w_out = F.in[9], *g_ffn = F.in[10], *w1 = F.in[11], *w2 = F.in[12], *g_ple = F.in[13], *wg = F.in[14], *wp = F.in[15];
    bf16 *Win_t = (bf16*)(F.ws + WS_WIN), *Wout_t = (bf16*)(F.ws + WS_WOUT), *W1_t = (bf16*)(F.ws + WS_W1), *W2_t = (bf16*)(F.ws + WS_W2), *Wg_t = (bf16*)(F.ws + WS_WG), *Wp_t = (bf16*)(F.ws + WS_WP);
    constexpr int I_IN = (D / 64) * (NIN / 32), I_OUT = (D / 64) * (D / 32), I_1 = (D / 64) * (FF / 32), I_2 = (FF / 64) * (D / 32), I_G = I_OUT, I_P = (PLE / 64) * (D / 32);
    constexpr int NITEMS = I_IN + I_OUT + I_1 + I_2 + I_G + I_P;
    for (int it = (part == 0 ? gw : I_IN + gw); it < (part == 0 ? I_IN : NITEMS); it += NGW) {
        int r = it;
        if (r < I_IN) { const int nb = r % (NIN / 32), kb = r / (NIN / 32); p0_transpose_item(w_in, D, NIN, Win_t, win_rowmap(32 * nb), 64 * kb, 32 * nb, nullptr, scr, F.lane); continue; } r -= I_IN;
        if (r < I_OUT) { const int nb = r % (D / 32), kb = r / (D / 32); p0_transpose_item(w_out, D, D, Wout_t, 32 * nb, 64 * kb, 32 * nb, nullptr, scr, F.lane); continue; } r -= I_OUT;
        if (r < I_1) { const int nb = r % (FF / 32), kb = r / (FF / 32); p0_transpose_item(w1, D, FF, W1_t, 32 * nb, 64 * kb, 32 * nb, g_ffn, scr, F.lane); continue; } r -= I_1;
        if (r < I_2) { const int nb = r % (D / 32), kb = r / (D / 32); p0_transpose_item(w2, FF, D, W2_t, 32 * nb, 64 * kb, 32 * nb, nullptr, scr, F.lane); continue; } r -= I_2;
        if (r < I_G) { const int nb = r % (D / 32), kb = r / (D / 32); p0_transpose_item(wg, D, D, Wg_t, 32 * nb, 64 * kb, 32 * nb, g_ple, scr, F.lane); continue; } r -= I_G;
        { const int nb = r % (D / 32), kb = r / (D / 32); p0_transpose_item(wp, PLE, D, Wp_t, 32 * nb, 64 * kb, 32 * nb, nullptr, scr, F.lane); }
    }
    const int gt = F.vcu * (NWAVES * 64) + F.tid, NGT = F.G * NWAVES * 64;
    if (part == 0) { bf16* Wm = (bf16*)(F.ws + WS_WM);
      for (int i = gt; i < 8 * 128 * 128; i += NGT) { const int s = i & 127, t = (i >> 7) & 127, g = i >> 14;
        Wm[((((g * 4 + (t >> 5)) * 8 + (s >> 4)) * 64 + ((s >> 3) & 1) * 32 + (t & 31)) << 3) + (s & 7)] = (bf16)f2bf(s <= t ? w_s[i] : 0.f); } }
    if (part == 0) { float* lut = (float*)(F.ws + WS_LUT);
      for (int i = gt; i < 16 * 1024; i += NGT) { const int h = i >> 10, dist = i & 1023; lut[i] = rel[rel_bucket(dist) * 16 + h] * LOG2E; }
      if (gt < 16) { float mb = -INFINITY; for (int k = 0; k < 32; ++k) mb = fmaxf(mb, rel[k * 16 + gt]); lut[16 * 1024 + gt] = mb * LOG2E; } }
    if (part == 1) { bf16* Pb = (bf16*)(F.ws + WS_PB);
      for (int i = gt; i < M * PLE / 8; i += NGT) { const f32x4 a = ((const f32x4*)p)[2 * i], b = ((const f32x4*)p)[2 * i + 1];
        v4u o; o.x = pk2(a.x, a.y); o.y = pk2(a.z, a.w); o.z = pk2(b.x, b.y); o.w = pk2(b.z, b.w); ((v4u*)Pb)[i] = o; } }
    if (part == 0) { bf16* Hn = (bf16*)F.out;
      f32x4 gv[4];
#pragma unroll
      for (int j = 0; j < 4; ++j) gv[j] = ((const f32x4*)g_mix)[F.lane + 64 * j];
      for (int m = gw; m < M; m += NGW) { const f32x4* xr = (const f32x4*)(x + (size_t)m * D) + F.lane; f32x4 v[4]; float s = 0.f;
#pragma unroll
        for (int j = 0; j < 4; ++j) { v[j] = xr[64 * j]; s += (v[j].x * v[j].x + v[j].y * v[j].y) + (v[j].z * v[j].z + v[j].w * v[j].w); }
        const float rs = 1.0f / sqrtf(wave_sum(s) * (1.0f / D) + EPS);
        unsigned long long* o8 = (unsigned long long*)(Hn + (size_t)m * D) + F.lane;
#pragma unroll
        for (int j = 0; j < 4; ++j) o8[64 * j] = (unsigned long long)pk2(v[j].x * rs * gv[j].x, v[j].y * rs * gv[j].y) | ((unsigned long long)pk2(v[j].z * rs * gv[j].z, v[j].w * rs * gv[j].w) << 32); } }
}

__device__ __forceinline__ void attn_simple(Frame& F) {
    LAS float* pbuf = (LAS float*)(F.lds + RING_OFF) + F.wave * 1024;
    const int gw = F.vcu * NWAVES + F.wave, NGW = F.G * NWAVES, lane = F.lane;
    const bf16 *Q = (const bf16*)(F.ws + WS_Q), *K = (const bf16*)(F.ws + WS_K), *VA = (const bf16*)(F.ws + WS_VA);
    const float *kmean = (const float*)(F.ws + WS_CTL + CT_KMEAN), *lut = (const float*)(F.ws + WS_LUT);
    bf16* YB = (bf16*)((unsigned char*)F.out + 32 * MiB);
    for (int item = gw; item < BATCH * H * SEQ; item += NGW) {
        const int t = item & (SEQ - 1), bh = item >> 13, b = bh >> 4, h = bh & 15, own = t >> 8;
        const size_t rowq = (size_t)b * SEQ + t;
        float q[64];
        { const v4u* qp = (const v4u*)(Q + rowq * D + h * HD);
#pragma unroll
          for (int i = 0; i < 8; ++i) { const v4u w = qp[i]; q[8 * i] = bflo(w.x); q[8 * i + 1] = bfhi(w.x); q[8 * i + 2] = bflo(w.y); q[8 * i + 3] = bfhi(w.y); q[8 * i + 4] = bflo(w.z); q[8 * i + 5] = bfhi(w.z); q[8 * i + 6] = bflo(w.w); q[8 * i + 7] = bfhi(w.w); } }
        float g = -INFINITY;
        if (lane < own) { const f32x4* km = (const f32x4*)(kmean + (size_t)(b * 32 + lane) * D + h * HD); float a = 0.f;
#pragma unroll
            for (int i = 0; i < 16; ++i) { const f32x4 kv = km[i]; a += q[4 * i] * kv.x + q[4 * i + 1] * kv.y + q[4 * i + 2] * kv.z + q[4 * i + 3] * kv.w; }
            g = a; }
        int sel[3];
#pragma unroll
        for (int r = 0; r < 3; ++r) { const float mg = wave_max(g); int idx = (g == mg && mg > -INFINITY) ? lane : 64; idx = wave_min_i(idx); sel[r] = idx; if (lane == idx) g = -INFINITY; }
        float sv[4][4]; float mx = -INFINITY;
#pragma unroll
        for (int blk = 0; blk < 4; ++blk) { const int n = blk < 3 ? sel[blk] : own;
#pragma unroll
            for (int kg = 0; kg < 4; ++kg) { float s = -INFINITY;
                if (n < 64) { const int kpos = n * 256 + kg * 64 + lane; const v4u* kp = (const v4u*)(K + ((size_t)b * SEQ + kpos) * D + h * HD); float a = 0.f;
#pragma unroll
                    for (int i = 0; i < 8; ++i) { const v4u w = kp[i]; a += q[8 * i] * bflo(w.x) + q[8 * i + 1] * bfhi(w.x) + q[8 * i + 2] * bflo(w.y) + q[8 * i + 3] * bfhi(w.y) + q[8 * i + 4] * bflo(w.z) + q[8 * i + 5] * bfhi(w.z) + q[8 * i + 6] * bflo(w.w) + q[8 * i + 7] * bfhi(w.w); }
                    const int dist = t - kpos; if (dist >= 0) s = a + lut[h * 1024 + (dist < 1023 ? dist : 1023)]; }
                sv[blk][kg] = s; mx = fmaxf(mx, s); } }
        mx = wave_max(mx);
        float l = 0.f;
#pragma unroll
        for (int blk = 0; blk < 4; ++blk)
#pragma unroll
            for (int kg = 0; kg < 4; ++kg) { const float pe = __builtin_amdgcn_exp2f(sv[blk][kg] - mx); l += pe; pbuf[blk * 256 + kg * 64 + lane] = pe; }
        l = wave_sum(l);
        LDS_WAIT(); asm volatile("" ::: "memory");
        float o = 0.f;
#pragma unroll
        for (int blk = 0; blk < 4; ++blk) { const int n = blk < 3 ? sel[blk] : own;
            if (n < 64) { const bf16* vp = VA + ((size_t)b * SEQ + n * 256) * D + h * HD + lane;
#pragma unroll 8
                for (int key = 0; key < 256; ++key) o += pbuf[blk * 256 + key] * __uint_as_float((unsigned)vp[(size_t)key * D] << 16); } }
        YB[rowq * D + h * HD + lane] = (bf16)f2bf(o / l);
        LDS_WAIT(); asm volatile("" ::: "memory");
    }
}
__device__ __forceinline__ void sgu_simple(Frame& F) {
    LAS float* vn = (LAS float*)(F.lds + RING_OFF);
    const bf16 *UG = (const bf16*)(F.ws + WS_UG), *VS = (const bf16*)(F.ws + WS_VS), *GB = (const bf16*)(F.ws + WS_GB), *YB = (const bf16*)((unsigned char*)F.out + 32 * MiB);
    bf16* MG = (bf16*)F.out;
    const float *stats = (const float*)(F.ws + WS_CTL + CT_STATS1), *w_s = F.in[4], *b_s = F.in[5], *lng = F.in[6], *lnb = F.in[7];
    const int ch = F.tid & 255, th = __builtin_amdgcn_readfirstlane(F.tid >> 8);
    for (int item = F.vcu; item < (M / 128) * 4; item += F.G) {
        const int c = item >> 2, qd = item & 3, col = 256 * qd + ch;
        __syncthreads();
        { const float lg = lng[col], lb = lnb[col];
          for (int s = th; s < 128; s += 2) { const size_t row = (size_t)c * 128 + s; const float s1 = stats[2 * row], s2 = stats[2 * row + 1];
            const float mu = s1 * (1.0f / 1024.0f), var = fmaxf(s2 * (1.0f / 1024.0f) - mu * mu, 0.f), rs = 1.0f / sqrtf(var + EPS);
            vn[s * 256 + ch] = (__uint_as_float((unsigned)VS[row * D + col] << 16) - mu) * rs * lg + lb; } }
        __syncthreads();
        const int g = __builtin_amdgcn_readfirstlane(col >> 7);
        for (int tt = 0; tt < 64; ++tt) { const int t = 64 * th + tt; const float* wr_ = w_s + ((size_t)g * 128 + t) * 128; float a = 0.f;
            for (int s = 0; s <= t; ++s) a += wr_[s] * vn[s * 256 + ch];
            const float mixed = a + b_s[g * 128 + t];
            const size_t off = ((size_t)c * 128 + t) * D + col;
            const float ug = __uint_as_float((unsigned)UG[off] << 16), gb = __uint_as_float((unsigned)GB[off] << 16), yb = __uint_as_float((unsigned)YB[off] << 16);
            MG[off] = (bf16)f2bf(ug * mixed + gb * yb); }
    }
    __syncthreads();
}

typedef short v4i16_t __attribute__((ext_vector_type(4)));
typedef unsigned u32x4_t __attribute__((ext_vector_type(4)));
typedef float f32x16 __attribute__((ext_vector_type(16)));
typedef LAS const unsigned char* lds_cptr;
__device__ __forceinline__ v4i16_t vtr(lds_cptr p) { return __builtin_amdgcn_ds_read_tr16_b64_v4i16((LAS v4i16_t*)p); }
__device__ __forceinline__ bf16x8 cat8(v4i16_t a, v4i16_t b) { return (bf16x8){a[0], a[1], a[2], a[3], b[0], b[1], b[2], b[3]}; }
__device__ __forceinline__ unsigned cvtpk(float lo, float hi) { unsigned r; asm("v_cvt_pk_bf16_f32 %0, %1, %2" : "=v"(r) : "v"(lo), "v"(hi)); return r; }
__device__ __forceinline__ int crow(int r, int hi) { return (r & 3) + 8 * (r >> 2) + 4 * hi; }
__device__ __forceinline__ bool p2_item(int vcu, int i, int& bh, int& qb) { if (i >= 4) return false; const int s = vcu & 7; bh = vcu >> 3;
    const unsigned w = s == 0 ? 0x0406161bu : s == 1 ? 0x0112131au : s == 2 ? 0x080b0c1du : s == 3 ? 0x0209171fu : s == 4 ? 0x030d111cu : s == 5 ? 0x050f1015u : s == 6 ? 0x00141819u : 0x070a0e1eu;
    qb = (int)((w >> (8 * i)) & 0xffu); return true; }

template <bool YB_GLOBAL>
__device__ __forceinline__ void sgu_item(Frame& F, int b, int h, int qb, LAS unsigned char* stage, const LAS float* Ost, const LAS float* Lst) {
    const bf16 *UG = (const bf16*)(F.ws + WS_UG), *VS = (const bf16*)(F.ws + WS_VS), *GB = (const bf16*)(F.ws + WS_GB), *YB = (const bf16*)((unsigned char*)F.out + 32 * MiB), *Wm = (const bf16*)(F.ws + WS_WM);
    bf16* MG = (bf16*)F.out;
    const float *stats = (const float*)(F.ws + WS_CTL + CT_STATS1), *b_s = F.in[5], *lng = F.in[6], *lnb = F.in[7];
    int tid_ = threadIdx.x; asm volatile("" : "+v"(tid_));
    const int lane = tid_ & 63, r32 = lane & 31, hi = lane >> 5, w = F.wave;
    const size_t row_base = (size_t)b * SEQ + 256 * qb;
    const int cc = w >> 2, tc = w & 3, g = h >> 1;
    v4u wv[4]; float s1[4], s2[4]; unsigned long long stq[4];
#pragma unroll
    for (int i = 0; i < 4; ++i) { const float* sp_ = stats + 2 * (row_base + ((F.tid + 512 * i) >> 3)); asm volatile("global_load_dwordx2 %0, %1, off" : "=v"(stq[i]) : "v"(sp_)); }
#pragma unroll
    for (int i = 0; i < 4; ++i) { const int id = F.tid + 512 * i, srow = id >> 3, pc = id & 7; const size_t row = row_base + srow;
        wv[i] = *(const v4u*)(VS + row * D + 64 * h + 8 * pc); }
    const int pc0 = F.tid & 7;
    const f32x4 g0 = *(const f32x4*)(lng + 64 * h + 8 * pc0), g1 = *(const f32x4*)(lng + 64 * h + 8 * pc0 + 4), c0 = *(const f32x4*)(lnb + 64 * h + 8 * pc0), c1 = *(const f32x4*)(lnb + 64 * h + 8 * pc0 + 4);
    const bf16* wrow = Wm + (size_t)(g * 4 + tc) * 4096 + lane * 8;
    bf16x8 wf[8];
#pragma unroll
    for (int st = 0; st < 8; ++st) wf[st] = *(const bf16x8*)(wrow + 512 * (st < 2 * (tc + 1) ? st : 0));
    const float bs = b_s[g * 128 + 32 * tc + r32];
    asm volatile("s_waitcnt vmcnt(0)" : "+v"(stq[0]), "+v"(stq[1]), "+v"(stq[2]), "+v"(stq[3]) :: "memory");
#pragma unroll
    for (int i = 0; i < 4; ++i) { s1[i] = __uint_as_float((unsigned)stq[i]); s2[i] = __uint_as_float((unsigned)(stq[i] >> 32)); }
#pragma unroll
    for (int i = 0; i < 4; ++i) { const int id = F.tid + 512 * i, srow = id >> 3, pc = id & 7;
        const float mu = s1[i] * (1.0f / 1024.0f), var = fmaxf(s2[i] * (1.0f / 1024.0f) - mu * mu, 0.f), rs = 1.0f / sqrtf(var + EPS);
        v4u o;
        o.x = pk2((bflo(wv[i].x) - mu) * rs * g0.x + c0.x, (bfhi(wv[i].x) - mu) * rs * g0.y + c0.y); o.y = pk2((bflo(wv[i].y) - mu) * rs * g0.z + c0.z, (bfhi(wv[i].y) - mu) * rs * g0.w + c0.w);
        o.z = pk2((bflo(wv[i].z) - mu) * rs * g1.x + c1.x, (bfhi(wv[i].z) - mu) * rs * g1.y + c1.y); o.w = pk2((bflo(wv[i].w) - mu) * rs * g1.z + c1.z, (bfhi(wv[i].w) - mu) * rs * g1.w + c1.w);
        *(LAS v4u*)(stage + srow * 128 + pc * 16) = o; }
    v4u ugv[4], gbv[4];
#pragma unroll
    for (int i = 0; i < 4; ++i) { const int id = F.tid + 512 * i; const size_t off = (row_base + (id >> 3)) * D + 64 * h + 8 * (id & 7); ugv[i] = *(const v4u*)(UG + off); gbv[i] = *(const v4u*)(GB + off); }
    __syncthreads();
    f32x16 acc[2];
#pragma unroll
    for (int r = 0; r < 16; ++r) { acc[0][r] = 0.f; acc[1][r] = 0.f; }
    const lds_cptr abase = (lds_cptr)stage + cc * 16384 + (8 * hi + ((lane & 15) >> 2)) * 128 + (16 * ((lane >> 4) & 1) + 4 * (lane & 3)) * 2;
#pragma unroll
    for (int st = 0; st < 8; ++st) if (st < 2 * (tc + 1)) {
#pragma unroll
        for (int ct = 0; ct < 2; ++ct) { const lds_cptr ap = abase + st * 2048 + ct * 64;
            const bf16x8 af = cat8(vtr(ap), vtr(ap + 512));
            acc[ct] = __builtin_amdgcn_mfma_f32_32x32x16_bf16(af, wf[st], acc[ct], 0, 0, 0); }
    }
    __syncthreads();
    {   LAS unsigned char* mrow = stage + (32 * w + r32) * 144 + 8 * hi;
#pragma unroll
        for (int ct = 0; ct < 2; ++ct)
#pragma unroll
            for (int rg = 0; rg < 4; ++rg)
                *(LAS unsigned long long*)(mrow + (32 * ct + 8 * rg) * 2) = (unsigned long long)cvtpk(acc[ct][4 * rg] + bs, acc[ct][4 * rg + 1] + bs) | ((unsigned long long)cvtpk(acc[ct][4 * rg + 2] + bs, acc[ct][4 * rg + 3] + bs) << 32); }
    __syncthreads();
#pragma unroll
    for (int i = 0; i < 4; ++i) { const int id = F.tid + 512 * i, trow = id >> 3, pc = id & 7; const size_t off = (row_base + trow) * D + 64 * h + 8 * pc;
        const v4u mw = *(const LAS v4u*)(stage + trow * 144 + pc * 16);
        float yb[8];
        if (YB_GLOBAL) { const v4u yw = *(const v4u*)(YB + off); yb[0] = bflo(yw.x); yb[1] = bfhi(yw.x); yb[2] = bflo(yw.y); yb[3] = bfhi(yw.y); yb[4] = bflo(yw.z); yb[5] = bfhi(yw.z); yb[6] = bflo(yw.w); yb[7] = bfhi(yw.w); }
        else { const float rl = 1.0f / Lst[trow]; const f32x4 o0 = *(const LAS f32x4*)(Ost + trow * 68 + 8 * pc), o1 = *(const LAS f32x4*)(Ost + trow * 68 + 8 * pc + 4);
            yb[0] = o0.x * rl; yb[1] = o0.y * rl; yb[2] = o0.z * rl; yb[3] = o0.w * rl; yb[4] = o1.x * rl; yb[5] = o1.y * rl; yb[6] = o1.z * rl; yb[7] = o1.w * rl; }
        const float mx[8] = {bflo(mw.x), bfhi(mw.x), bflo(mw.y), bfhi(mw.y), bflo(mw.z), bfhi(mw.z), bflo(mw.w), bfhi(mw.w)};
        const float ug[8] = {bflo(ugv[i].x), bfhi(ugv[i].x), bflo(ugv[i].y), bfhi(ugv[i].y), bflo(ugv[i].z), bfhi(ugv[i].z), bflo(ugv[i].w), bfhi(ugv[i].w)};
        const float gb[8] = {bflo(gbv[i].x), bfhi(gbv[i].x), bflo(gbv[i].y), bfhi(gbv[i].y), bflo(gbv[i].z), bfhi(gbv[i].z), bflo(gbv[i].w), bfhi(gbv[i].w)};
        v4u o;
        o.x = cvtpk(ug[0] * mx[0] + gb[0] * yb[0], ug[1] * mx[1] + gb[1] * yb[1]); o.y = cvtpk(ug[2] * mx[2] + gb[2] * yb[2], ug[3] * mx[3] + gb[3] * yb[3]);
        o.z = cvtpk(ug[4] * mx[4] + gb[4] * yb[4], ug[5] * mx[5] + gb[5] * yb[5]); o.w = cvtpk(ug[6] * mx[6] + gb[6] * yb[6], ug[7] * mx[7] + gb[7] * yb[7]);
        *(v4u*)(MG + off) = o; }
    __syncthreads();
}
__device__ __forceinline__ void sgu_fast(Frame& F) {
    int bh, qb;
    for (int i = 0; p2_item(F.vcu, i, bh, qb); ++i) sgu_item<true>(F, bh >> 4, bh & 15, qb, F.lds + RING_OFF, nullptr, nullptr);
}

#define LBAR() asm volatile("s_waitcnt lgkmcnt(0)\n\ts_barrier" ::: "memory")
#define PBAR() asm volatile("s_barrier" ::: "memory")
constexpr int OP = 68;
constexpr int QP = 144;
constexpr int TB = 1280, TN = 1537;
constexpr int A_OST = 0, A_LST = 69632, A_MQ = 70656, A_CNT = 71680, A_LIST = 71808, A_LUT = 80000, A_Q = 86160, A_P = 123024, A_END = 156816;
constexpr int PB = 528, PBUF = 32 * PB;
static_assert(A_Q % 16 == 0 && A_P % 16 == 0 && A_LUT + TN * 4 <= A_Q && A_Q + 256 * QP == A_P && A_P + 2 * PBUF == A_END && A_END <= LDSCTL_OFF, "P2 LDS map");
__device__ __forceinline__ void attn_item(Frame& F, int b, int h, int own, int probe = 0) {
    LAS unsigned char* L = F.lds;
    LAS float* Ost = (LAS float*)(L + A_OST); LAS float* Lst = (LAS float*)(L + A_LST); LAS float* MQ = (LAS float*)(L + A_MQ); LAS int* cnt = (LAS int*)(L + A_CNT);
    LAS unsigned char* list = L + A_LIST; LAS float* km = (LAS float*)(L + A_P); LAS float* lut = (LAS float*)(L + A_LUT);
    const bf16 *Qb = (const bf16*)(F.ws + WS_Q) + ((size_t)b * SEQ + 256 * own) * D + 64 * h, *Kb = (const bf16*)(F.ws + WS_K) + (size_t)b * SEQ * D + 64 * h;
    const float *kmean = (const float*)(F.ws + WS_CTL + CT_KMEAN), *glut = (const float*)(F.ws + WS_LUT) + h * 1024, *rel = F.in[8];
    const unsigned* khmax = (const unsigned*)(F.ws + WS_CTL + CT_KHMAX);
    int tid_ = threadIdx.x; asm volatile("" : "+v"(tid_));
    const int tid = tid_, lane = tid & 63, r32 = lane & 31, hi = lane >> 5, w = F.wave, l15 = lane & 15, kg = lane >> 4, ds = w & 3;
    const bf16 *Kf = (const bf16*)(F.ws + WS_K) + (size_t)(b * 16 + h) * (32 * 16384), *Vf = (const bf16*)(F.ws + WS_VA) + (size_t)(b * 16 + h) * (32 * 16384);
    u32x4_t f0[8];
    if (w < 4) { const bf16* kp_ = Kf + w * 4096 + lane * 8;
#pragma unroll
        for (int t = 0; t < 2; ++t)
#pragma unroll
            for (int ks = 0; ks < 4; ++ks) f0[4 * t + ks] = *(const u32x4_t*)(kp_ + t * 2048 + ks * 512); }
    else { const bf16* vp_ = Vf + ds * 4096 + lane * 8;
#pragma unroll
        for (int st = 0; st < 8; ++st) f0[st] = *(const u32x4_t*)(vp_ + st * 512); }
    float kmv[4], tbv[4]; v4u qv[4];
#pragma unroll
    for (int j = 0; j < 4; ++j) { const int i = tid + 512 * j; kmv[j] = i < own * 64 ? kmean[(size_t)(b * 32 + (i >> 6)) * D + 64 * h + (i & 63)] : 0.f; }
#pragma unroll
    for (int j = 0; j < 4; ++j) { const int i = tid + 512 * j; const int dist = TB - i; tbv[j] = (i < TN && dist >= 0) ? glut[dist < 1023 ? dist : 1023] : -INFINITY; }
#pragma unroll
    for (int i = 0; i < 4; ++i) { const int id = tid + 512 * i; qv[i] = *(const v4u*)(Qb + (size_t)(id >> 3) * D + 8 * (id & 7)); }
    const float maxbl = ((const float*)(F.ws + WS_LUT))[16 * 1024 + h], khm0 = __uint_as_float(khmax[b * 32 + 2 * h]), khm1 = __uint_as_float(khmax[b * 32 + 2 * h + 1]);
    for (int i = tid; i < 256 * OP; i += 512) Ost[i] = 0.f;
    if (tid < 256) Lst[tid] = 0.f;
    if (tid < 32) cnt[tid] = 0;
#pragma unroll
    for (int j = 0; j < 4; ++j) { const int i = tid + 512 * j; if (i < own * 64) km[i] = kmv[j]; }
#pragma unroll
    for (int j = 0; j < 4; ++j) { const int i = tid + 512 * j; if (i < TN) lut[i] = tbv[j]; }
#pragma unroll
    for (int i = 0; i < 4; ++i) { const int id = tid + 512 * i; *(LAS v4u*)(L + A_Q + (id >> 3) * QP + (id & 7) * 16) = qv[i]; }
    __syncthreads();
    {
        const LAS unsigned char* qp = L + A_Q + (32 * w + r32) * QP + 16 * hi;
        bf16x8 qf[4];
#pragma unroll
        for (int ks = 0; ks < 4; ++ks) qf[ks] = *(const LAS bf16x8*)(qp + 32 * ks);
        f32x16 G;
#pragma unroll
        for (int r = 0; r < 16; ++r) G[r] = 0.f;
        const LAS float* kr = km + r32 * 64 + 8 * hi;
#pragma unroll
        for (int ks = 0; ks < 4; ++ks) { const f32x4 a = *(const LAS f32x4*)(kr + 16 * ks), c = *(const LAS f32x4*)(kr + 16 * ks + 4);
            const float x[8] = {a.x, a.y, a.z, a.w, c.x, c.y, c.z, c.w}; unsigned hb[8], lb[8];
#pragma unroll
            for (int j = 0; j < 8; ++j) { hb[j] = f2bf(x[j]); lb[j] = f2bf(x[j] - __uint_as_float(hb[j] << 16)); }
            u32x4_t hw, lw; hw.x = hb[0] | (hb[1] << 16); hw.y = hb[2] | (hb[3] << 16); hw.z = hb[4] | (hb[5] << 16); hw.w = hb[6] | (hb[7] << 16);
            lw.x = lb[0] | (lb[1] << 16); lw.y = lb[2] | (lb[3] << 16); lw.z = lb[4] | (lb[5] << 16); lw.w = lb[6] | (lb[7] << 16);
            G = __builtin_amdgcn_mfma_f32_32x32x16_bf16(__builtin_bit_cast(bf16x8, hw), qf[ks], G, 0, 0, 0);
            G = __builtin_amdgcn_mfma_f32_32x32x16_bf16(__builtin_bit_cast(bf16x8, lw), qf[ks], G, 0, 0, 0); }
        float nlo = 0.f, nhi = 0.f;
#pragma unroll
        for (int ks = 0; ks < 4; ++ks) { const u32x4_t qw = __builtin_bit_cast(u32x4_t, qf[ks]);
            const float e[8] = {bflo(qw.x), bfhi(qw.x), bflo(qw.y), bfhi(qw.y), bflo(qw.z), bfhi(qw.z), bflo(qw.w), bfhi(qw.w)}; float t = 0.f;
#pragma unroll
            for (int j = 0; j < 8; ++j) t += e[j] * e[j];
            if (ks < 2) nlo += t; else nhi += t; }
        nlo += __shfl_xor(nlo, 32); nhi += __shfl_xor(nhi, 32);
        if (hi == 0) MQ[32 * w + r32] = sqrtf(nlo) * khm0 + sqrtf(nhi) * khm1 + maxbl + 0.01f;
        float v0 = -INFINITY, v1 = -INFINITY, v2 = -INFINITY; int i0 = 64, i1 = 64, i2 = 64;
#pragma unroll
        for (int r = 0; r < 16; ++r) { const int n = (r & 3) + 8 * (r >> 2) + 4 * hi; const float g = n < own ? G[r] : -INFINITY;
            if (g > v0) { v2 = v1; i2 = i1; v1 = v0; i1 = i0; v0 = g; i0 = n; } else if (g > v1) { v2 = v1; i2 = i1; v1 = g; i1 = n; } else if (g > v2) { v2 = g; i2 = n; } }
        const float pv[3] = {__shfl_xor(v0, 32), __shfl_xor(v1, 32), __shfl_xor(v2, 32)}; const int pi[3] = {__shfl_xor(i0, 32), __shfl_xor(i1, 32), __shfl_xor(i2, 32)};
#pragma unroll
        for (int k = 0; k < 3; ++k) { const float g = pv[k]; const int n = pi[k];
            if (g > v0 || (g == v0 && n < i0)) { v2 = v1; i2 = i1; v1 = v0; i1 = i0; v0 = g; i0 = n; }
            else if (g > v1 || (g == v1 && n < i1)) { v2 = v1; i2 = i1; v1 = g; i1 = n; }
            else if (g > v2 || (g == v2 && n < i2)) { v2 = g; i2 = n; } }
        if (hi == 0) { const int qid = 32 * w + r32;
            if (v0 > -INFINITY) { const int pos = __hip_atomic_fetch_add(cnt + i0, 1, __ATOMIC_RELAXED, __HIP_MEMORY_SCOPE_WORKGROUP); list[i0 * 256 + pos] = (unsigned char)qid; }
            if (v1 > -INFINITY) { const int pos = __hip_atomic_fetch_add(cnt + i1, 1, __ATOMIC_RELAXED, __HIP_MEMORY_SCOPE_WORKGROUP); list[i1 * 256 + pos] = (unsigned char)qid; }
            if (v2 > -INFINITY) { const int pos = __hip_atomic_fetch_add(cnt + i2, 1, __ATOMIC_RELAXED, __HIP_MEMORY_SCOPE_WORKGROUP); list[i2 * 256 + pos] = (unsigned char)qid; } }
    }
    __syncthreads();
    const float bias31 = lut[TB - 1023];
#define NCHUNKS(n_) ((n_) == own ? 8 : max(1, (cnt[(n_)] + 31) >> 5))
    if (!(probe & 1)) {
    if (w < 4) {
        float mitem = fmaxf(fmaxf(MQ[lane], MQ[lane + 64]), fmaxf(MQ[lane + 128], MQ[lane + 192])); mitem = wave_max(mitem);
        const bool useshift = mitem > 96.0f;
        const float shift = useshift ? mitem - 64.0f : 0.f;
        const f32x16 zero16 = {0.f, 0.f, 0.f, 0.f, 0.f, 0.f, 0.f, 0.f, 0.f, 0.f, 0.f, 0.f, 0.f, 0.f, 0.f, 0.f};
        const LAS unsigned char* qrd = L + A_Q + 16 * hi;
        LAS unsigned char* pwr_base = L + A_P + r32 * PB + 128 * w + 8 * hi;
        const bf16* Kw = Kf + w * 4096 + lane * 8;
        u32x4_t kA[2][4], kB[2][4];
        int buf = 0;
#define LOAD_K(dst, n_) do { const int nn_ = (probe & 4) ? 0 : ((n_) < own ? (n_) : own); const bf16* kp0_ = Kw + (size_t)nn_ * 16384; const bf16* kp1_ = kp0_ + 2048; \
        asm volatile("global_load_dwordx4 %0, %1, off" : "=v"(dst[0][0]) : "v"(kp0_)); asm volatile("global_load_dwordx4 %0, %1, off offset:1024" : "=v"(dst[0][1]) : "v"(kp0_)); \
        asm volatile("global_load_dwordx4 %0, %1, off offset:2048" : "=v"(dst[0][2]) : "v"(kp0_)); asm volatile("global_load_dwordx4 %0, %1, off offset:3072" : "=v"(dst[0][3]) : "v"(kp0_)); \
        asm volatile("global_load_dwordx4 %0, %1, off" : "=v"(dst[1][0]) : "v"(kp1_)); asm volatile("global_load_dwordx4 %0, %1, off offset:1024" : "=v"(dst[1][1]) : "v"(kp1_)); \
        asm volatile("global_load_dwordx4 %0, %1, off offset:2048" : "=v"(dst[1][2]) : "v"(kp1_)); asm volatile("global_load_dwordx4 %0, %1, off offset:3072" : "=v"(dst[1][3]) : "v"(kp1_)); } while (0)
#define WAIT_K(x) asm volatile("s_waitcnt vmcnt(8)" : "+v"(x[0][0]), "+v"(x[0][1]), "+v"(x[0][2]), "+v"(x[0][3]), "+v"(x[1][0]), "+v"(x[1][1]), "+v"(x[1][2]), "+v"(x[1][3]) :: "memory")
#define QK_BLOCK(n_, kf) do { const int nq = (n_); const bool isown = nq == own; const int count = isown ? 256 : qcnt; \
        const int ncq = __builtin_amdgcn_readfirstlane(isown ? 8 : max(1, (qcnt + 31) >> 5)); const bool near = (own - nq) <= 4; \
        const int ncnt_ = cnt[nq < 31 ? nq + 1 : 31];                     \
        for (int cq = 0; cq < ncq; ++cq) { \
            LAS unsigned char* pw = pwr_base + buf * PBUF; \
            const int li = 32 * cq + r32; \
            const int qi = isown ? li : (li < count ? qe : 0); \
            const int ne_ = (cq + 1 < ncq) ? (int)list[nq * 256 + li + 32] : (int)list[(nq + 1) * 256 + r32];     \
            if (probe & 8) { } else if (isown && 64 * w > 32 * cq + 31) {                         \
                _Pragma("unroll") for (int g = 0; g < 4; ++g) { *(LAS unsigned long long*)(pw + g * 16) = 0ull; *(LAS unsigned long long*)(pw + 64 + g * 16) = 0ull; } \
            } else { \
            const LAS unsigned char* qp = qrd + qi * QP; bf16x8 qf[4]; \
            _Pragma("unroll") for (int ks = 0; ks < 4; ++ks) qf[ks] = *(const LAS bf16x8*)(qp + 32 * ks); \
            const LAS float* tb = lut + (TB - (256 * (own - nq) + qi - 64 * w - 4 * hi)); \
            f32x16 S0 = __builtin_amdgcn_mfma_f32_32x32x16_bf16(__builtin_bit_cast(bf16x8, kf[0][0]), qf[0], zero16, 0, 0, 0); \
            f32x16 S1 = __builtin_amdgcn_mfma_f32_32x32x16_bf16(__builtin_bit_cast(bf16x8, kf[1][0]), qf[0], zero16, 0, 0, 0); \
            _Pragma("unroll") for (int ks = 1; ks < 4; ++ks) { S0 = __builtin_amdgcn_mfma_f32_32x32x16_bf16(__builtin_bit_cast(bf16x8, kf[0][ks]), qf[ks], S0, 0, 0, 0); S1 = __builtin_amdgcn_mfma_f32_32x32x16_bf16(__builtin_bit_cast(bf16x8, kf[1][ks]), qf[ks], S1, 0, 0, 0); } \
            if (useshift) { _Pragma("unroll") for (int r = 0; r < 16; ++r) { S0[r] -= shift; S1[r] -= shift; } } \
            if (near) { _Pragma("unroll") for (int r = 0; r < 16; ++r) S0[r] += tb[(r & 3) + 8 * (r >> 2)]; } \
            _Pragma("unroll") for (int r = 0; r < 16; ++r) S0[r] = __builtin_amdgcn_exp2f(S0[r]); \
            _Pragma("unroll") for (int g = 0; g < 4; ++g) \
                *(LAS unsigned long long*)(pw + g * 16) = (unsigned long long)cvtpk(S0[4 * g], S0[4 * g + 1]) | ((unsigned long long)cvtpk(S0[4 * g + 2], S0[4 * g + 3]) << 32); \
            asm volatile("" ::: "memory");                                 \
            if (near) { _Pragma("unroll") for (int r = 0; r < 16; ++r) S1[r] += tb[32 + (r & 3) + 8 * (r >> 2)]; } \
            _Pragma("unroll") for (int r = 0; r < 16; ++r) S1[r] = __builtin_amdgcn_exp2f(S1[r]); \
            _Pragma("unroll") for (int g = 0; g < 4; ++g) \
                *(LAS unsigned long long*)(pw + 64 + g * 16) = (unsigned long long)cvtpk(S1[4 * g], S1[4 * g + 1]) | ((unsigned long long)cvtpk(S1[4 * g + 2], S1[4 * g + 3]) << 32); \
            } \
            qe = ne_; \
            LBAR(); \
            buf ^= 1; } \
        qcnt = ncnt_; } while (0)
        int qe = (int)list[r32], qcnt = cnt[0];
#pragma unroll
        for (int t = 0; t < 2; ++t)
#pragma unroll
            for (int ks = 0; ks < 4; ++ks) kA[t][ks] = f0[4 * t + ks];
        for (int n = 0; ; n += 2) {
            LOAD_K(kB, n + 1); WAIT_K(kA); QK_BLOCK(n, kA);
            if (n + 1 > own) break;
            LOAD_K(kA, n + 2); WAIT_K(kB); QK_BLOCK(n + 1, kB);
            if (n + 2 > own) break;
        }
        asm volatile("s_waitcnt vmcnt(0)" ::: "memory");
        LBAR();
#undef WAIT_K
#undef LOAD_K
#undef QK_BLOCK
    } else {
        const LAS unsigned char* prd_base = L + A_P + l15 * PB + kg * 16;
        const bf16* Vw = Vf + ds * 4096 + lane * 8;
        const float sc31 = __builtin_amdgcn_exp2f(bias31);
        const bf16x8 ones = {(short)0x3f80, (short)0x3f80, (short)0x3f80, (short)0x3f80, (short)0x3f80, (short)0x3f80, (short)0x3f80, (short)0x3f80};
        u32x4_t vA[8], vB[8];
        int buf = 0;
#define LOAD_VT(dst, n_) do { const int nn_ = (probe & 4) ? 0 : ((n_) < own ? (n_) : own); const bf16* vp_ = Vw + (size_t)nn_ * 16384; const bf16* vq_ = vp_ + 2048; \
        asm volatile("global_load_dwordx4 %0, %1, off" : "=v"(dst[0]) : "v"(vp_)); asm volatile("global_load_dwordx4 %0, %1, off offset:1024" : "=v"(dst[1]) : "v"(vp_)); \
        asm volatile("global_load_dwordx4 %0, %1, off offset:2048" : "=v"(dst[2]) : "v"(vp_)); asm volatile("global_load_dwordx4 %0, %1, off offset:3072" : "=v"(dst[3]) : "v"(vp_)); \
        asm volatile("global_load_dwordx4 %0, %1, off" : "=v"(dst[4]) : "v"(vq_)); asm volatile("global_load_dwordx4 %0, %1, off offset:1024" : "=v"(dst[5]) : "v"(vq_)); \
        asm volatile("global_load_dwordx4 %0, %1, off offset:2048" : "=v"(dst[6]) : "v"(vq_)); asm volatile("global_load_dwordx4 %0, %1, off offset:3072" : "=v"(dst[7]) : "v"(vq_)); } while (0)
#define WAIT_V(x) asm volatile("s_waitcnt vmcnt(8)" : "+v"(x[0]), "+v"(x[1]), "+v"(x[2]), "+v"(x[3]), "+v"(x[4]), "+v"(x[5]), "+v"(x[6]), "+v"(x[7]) :: "memory")
#define PV_BLOCK(n_, vfr) do { const int np = (n_); const bool isown = np == own; const int count = isown ? 256 : pcnt; \
        const int ncp = __builtin_amdgcn_readfirstlane(isown ? 8 : max(1, (pcnt + 31) >> 5)); const float scf = (own - np) <= 4 ? 1.0f : sc31; \
        const int ncnt_ = cnt[np < 31 ? np + 1 : 31]; \
        for (int cp = 0; cp < ncp; ++cp) { \
            const int li0 = 32 * cp + l15, li1 = li0 + 16; const bool valid0 = li0 < count, valid1 = li1 < count; \
            const int qi0 = isown ? li0 : (valid0 ? pe0 : 0), qi1 = isown ? li1 : (valid1 ? pe1 : 0); \
            const LAS unsigned char* nl_ = (cp + 1 < ncp) ? (list + np * 256 + li0 + 32) : (list + (np + 1) * 256 + l15); \
            const int ne0_ = (int)nl_[0], ne1_ = (int)nl_[16]; \
            if (!(probe & 16)) { \
            const LAS unsigned char* pr = prd_base + buf * PBUF; \
            LAS f32x4* op0 = (LAS f32x4*)(Ost + qi0 * OP + 16 * ds + 4 * kg); LAS f32x4* op1 = (LAS f32x4*)(Ost + qi1 * OP + 16 * ds + 4 * kg); \
            bf16x8 p0[4], p1[4]; \
            _Pragma("unroll") for (int st = 0; st < 4; ++st) { p0[st] = *(const LAS bf16x8*)(pr + st * 64); p1[st] = *(const LAS bf16x8*)(pr + 16 * PB + st * 64); } \
            const f32x4 o0 = *op0, o1 = *op1; \
            f32x4 a0 = {0.f, 0.f, 0.f, 0.f}, a1 = {0.f, 0.f, 0.f, 0.f}, l0 = {0.f, 0.f, 0.f, 0.f}, l1 = {0.f, 0.f, 0.f, 0.f}; \
            _Pragma("unroll") for (int st = 0; st < 4; ++st) { \
                a0 = __builtin_amdgcn_mfma_f32_16x16x32_bf16(__builtin_bit_cast(bf16x8, vfr[st]), p0[st], a0, 0, 0, 0); a1 = __builtin_amdgcn_mfma_f32_16x16x32_bf16(__builtin_bit_cast(bf16x8, vfr[st]), p1[st], a1, 0, 0, 0); \
                if (ds == 0) { l0 = __builtin_amdgcn_mfma_f32_16x16x32_bf16(ones, p0[st], l0, 0, 0, 0); l1 = __builtin_amdgcn_mfma_f32_16x16x32_bf16(ones, p1[st], l1, 0, 0, 0); } } \
            _Pragma("unroll") for (int st = 0; st < 4; ++st) { p0[st] = *(const LAS bf16x8*)(pr + (4 + st) * 64); p1[st] = *(const LAS bf16x8*)(pr + 16 * PB + (4 + st) * 64); } \
            _Pragma("unroll") for (int st = 0; st < 4; ++st) { \
                a0 = __builtin_amdgcn_mfma_f32_16x16x32_bf16(__builtin_bit_cast(bf16x8, vfr[4 + st]), p0[st], a0, 0, 0, 0); a1 = __builtin_amdgcn_mfma_f32_16x16x32_bf16(__builtin_bit_cast(bf16x8, vfr[4 + st]), p1[st], a1, 0, 0, 0); \
                if (ds == 0) { l0 = __builtin_amdgcn_mfma_f32_16x16x32_bf16(ones, p0[st], l0, 0, 0, 0); l1 = __builtin_amdgcn_mfma_f32_16x16x32_bf16(ones, p1[st], l1, 0, 0, 0); } } \
            if (ds == 0 && kg == 0) { if (valid0) Lst[qi0] += l0[0] * scf; if (valid1) Lst[qi1] += l1[0] * scf; } \
            if (valid0) *op0 = o0 + a0 * scf; \
            if (valid1) *op1 = o1 + a1 * scf; \
            } \
            pe0 = ne0_; pe1 = ne1_; \
            PBAR(); \
            buf ^= 1; } \
        pcnt = ncnt_; } while (0)
        int pe0 = (int)list[l15], pe1 = (int)list[16 + l15], pcnt = cnt[0];
#pragma unroll
        for (int st = 0; st < 8; ++st) vA[st] = f0[st];
        LBAR();
        for (int n = 0; ; n += 2) {
            LOAD_VT(vB, n + 1); WAIT_V(vA); PV_BLOCK(n, vA);
            if (n + 1 > own) break;
            LOAD_VT(vA, n + 2); WAIT_V(vB); PV_BLOCK(n + 1, vB);
            if (n + 2 > own) break;
        }
        asm volatile("s_waitcnt vmcnt(0)" ::: "memory");
#undef WAIT_V
#undef LOAD_VT
#undef PV_BLOCK
    }
    }
#undef NCHUNKS
}
__device__ __forceinline__ void p2_fast(Frame& F, int probe = 0) {
    int bh, qb;
    for (int v = F.vcu; v < 256; v += F.G) for (int i = 0; p2_item(v, i, bh, qb); ++i) { attn_item(F, bh >> 4, bh & 15, qb, probe);
        if (!(probe & 2)) sgu_item<false>(F, bh >> 4, bh & 15, qb, F.lds + A_Q, (const LAS float*)(F.lds + A_OST), (const LAS float*)(F.lds + A_LST)); }
}
__device__ __forceinline__ void final_norm(Frame& F) {
    const float *X3 = (const float*)(F.ws + WS_X1), *ss4 = (const float*)(F.ws + WS_CTL + CT_SS4), *gf = F.in[16];
    const int gw = F.vcu * NWAVES + F.wave, NGW = F.G * NWAVES;
    f32x4 gv[4];
#pragma unroll
    for (int j = 0; j < 4; ++j) gv[j] = ((const f32x4*)gf)[F.lane + 64 * j];
    for (int m = gw; m < M; m += NGW) { const float rs = 1.0f / sqrtf(ss4[m] * (1.0f / D) + EPS);
        const f32x4* xr = (const f32x4*)(X3 + (size_t)m * D) + F.lane; f32x4* o = (f32x4*)(F.out + (size_t)m * D) + F.lane;
#pragma unroll
        for (int j = 0; j < 4; ++j) o[64 * j] = xr[64 * j] * rs * gv[j]; }
}

#ifndef MK_N_LAUNCHES
#define MK_N_LAUNCHES 1
#endif
constexpr int N_PHASES = 8;
#ifndef PROBE_P2
#define PROBE_P2 -1
#endif
#ifndef P2FAST
#define P2FAST 1
#endif
struct Args { const float* in[17]; float* out; unsigned char* ws; int ph_lo, ph_hi; };
__global__ void __launch_bounds__(NWAVES * 64, 2) mk_fwd(Args args) {
    extern __shared__ __attribute__((aligned(16))) unsigned char lds[];
    Frame F;
    F.lds = (LAS unsigned char*)lds; F.MISC = (volatile LAS unsigned*)(F.lds + MISC_OFF);
    F.tid = threadIdx.x; F.lane = F.tid & 63; F.wave = __builtin_amdgcn_readfirstlane(F.tid >> 6);
    F.G = gridDim.x; { const int bx = blockIdx.x; F.vcu = (F.G % 8 == 0) ? (bx % 8) * (F.G / 8) + bx / 8 : bx; }
    F.ws = args.ws; F.out = args.out;
#pragma unroll
    for (int i = 0; i < 17; ++i) F.in[i] = args.in[i];
    for (int u = F.tid; u < (LDS_BYTES - LDSCTL_OFF) / 4; u += NWAVES * 64) ((LAS unsigned*)(F.lds + LDSCTL_OFF))[u] = 0u;
    __syncthreads();
    unsigned* barw = (unsigned*)(F.ws + WS_CTL + CT_BAR);
    XcdBarrier bar; bar.bar = barw; bar.x = 0; bar.st = nullptr;
    if (MK_N_LAUNCHES == 1) bar = xcd_barrier_post(barw, F.MISC + 8);
    const int lo = args.ph_lo, hi = args.ph_hi;
#define IN(k) (lo <= (k) && (k) < hi)
#define SEAM(k) do { if (IN(k) && IN((k) + 1)) xcd_barrier(bar); } while (0)
#define LSEAM(k) do { if (IN(k) && IN((k) + 1)) { if (grp_ok) quad_barrier(bar, (blockIdx.x & 7u) * 8u + ((blockIdx.x >> 3) & 7u)); else xcd_barrier(bar); } } while (0)
    bool grp_ok = false;
    float* ctl = (float*)(F.ws + WS_CTL);
    bf16* d0 = (bf16*)F.out; bf16* d1 = (bf16*)(F.ws + WS_K);
    if (IN(0)) { p0_prologue(F, 0); } SEAM(0);
    if (IN(1)) {
        pg8::Gemm g{d0, (const bf16*)(F.ws + WS_WIN), M, NIN, D}; pg8::StaticOrder S; S.init(M, NIN, F.G, (int)blockIdx.x);
        pg8::EpiIn E{(bf16*)(F.ws + WS_UG), (bf16*)(F.ws + WS_VS), (bf16*)(F.ws + WS_Q), (bf16*)(F.ws + WS_K), (bf16*)(F.ws + WS_VA), (bf16*)(F.ws + WS_GB),
                     (float*)(F.ws + WS_CTL + CT_STATS1), (float*)(F.ws + WS_CTL + CT_KMEAN), (unsigned*)(F.ws + WS_CTL + CT_KHMAX), F.lds + RING_BYTES};
        pg8::gemm_phase<pg8::EpiIn, pg8::StaticOrder, true, true>(F.lds + RING_OFF, g, S, E);
    } SEAM(1);
    if (IN(2)) { if (P2FAST) { if (PROBE_P2 >= 0) { int nrep = 2; asm volatile("" : "+s"(nrep)); for (int rep = 0; rep < nrep; ++rep) p2_fast(F, rep + 1 < nrep ? PROBE_P2 : 0); } else p2_fast(F, 0); p0_prologue(F, 1); } else { attn_simple(F); p0_prologue(F, 1); } } SEAM(2);
    if (IN(3)) { if (!P2FAST) sgu_fast(F); } if (!P2FAST || MK_N_LAUNCHES != 1) SEAM(3);
    if (MK_N_LAUNCHES == 1 && IN(4)) grp_ok = grp_local_ok(bar, F.MISC + 10);
    if (IN(4)) {
        pg8::Gemm g{d0, (const bf16*)(F.ws + WS_WOUT), M, D, D}; pg8::StaticOrder S; S.init(M, D, F.G, (int)blockIdx.x);
        pg8::EpiResid<false> E{F.in[0], d1, (float*)(F.ws + WS_CTL + CT_SS2), d1, 1 << 30};
        pg8::gemm_phase<pg8::EpiResid<false>, pg8::StaticOrder, true, true>(F.lds + RING_OFF, g, S, E);
    } LSEAM(4);
    if (MK_N_LAUNCHES == 1 && IN(4) && F.tid == 0) __hip_atomic_fetch_add((unsigned*)(F.ws + WS_CTL + CT_DONE3), 1u, __ATOMIC_RELAXED, __HIP_MEMORY_SCOPE_AGENT);
    if (IN(5)) {
        pg8::Gemm g{d1, (const bf16*)(F.ws + WS_W1), M, FF, D}; pg8::StaticOrder S; S.init(M, FF, F.G, (int)blockIdx.x);
        pg8::EpiFF1 E{(bf16*)(F.ws + WS_A), (const float*)(F.ws + WS_CTL + CT_SS2), EPS};
        pg8::gemm_phase<pg8::EpiFF1, pg8::StaticOrder, true, true>(F.lds + RING_OFF, g, S, E);
    } LSEAM(5);
    if (IN(6)) {
        pg8::Gemm g{(const bf16*)(F.ws + WS_A), (const bf16*)(F.ws + WS_W2), M, D, FF}; pg8::StaticOrder S; S.init(M, D, F.G, (int)blockIdx.x);
        pg8::EpiResid<true> E{d1, (bf16*)(F.ws + WS_X2B_LO), (float*)(F.ws + WS_CTL + CT_SS3), (bf16*)(F.ws + WS_X2B_HI), 8192};
        pg8::gemm_phase<pg8::EpiResid<true>, pg8::StaticOrder, true, true>(F.lds + RING_OFF, g, S, E);
    } LSEAM(6);
    if (MK_N_LAUNCHES == 1 && IN(7) && grp_ok) {
        if (F.tid == 0) { unsigned* c = (unsigned*)(F.ws + WS_CTL + CT_DONE3); unsigned sp = 0; while (__hip_atomic_load(c, __ATOMIC_RELAXED, __HIP_MEMORY_SCOPE_AGENT) < (unsigned)F.G) { __builtin_amdgcn_s_sleep(1); if (++sp > (1u << 22)) break; } }
        __syncthreads(); }
    if (IN(7)) {
        { int kple = PLE; asm volatile("" : "+s"(kple));
          pg8::Gemm g{(const bf16*)(F.ws + WS_PB), (const bf16*)(F.ws + WS_WP), M, D, kple}; pg8::StaticOrder S; S.init(M, D, F.G, (int)blockIdx.x);
          pg8::EpiStore E{(bf16*)(F.ws + WS_PP_LO), (bf16*)(F.ws + WS_PP_HI), PP_ROW2};
          pg8::gemm_phase<pg8::EpiStore, pg8::StaticOrder, true, true>(F.lds + RING_OFF, g, S, E); }
        asm volatile("s_waitcnt vmcnt(0)" ::: "memory"); __syncthreads();
        { pg8::Gemm g{(const bf16*)(F.ws + WS_X2B_LO), (const bf16*)(F.ws + WS_WG), M, D, D, (const bf16*)(F.ws + WS_X2B_HI), 32}; pg8::StaticOrder S; S.init(M, D, F.G, (int)blockIdx.x);
          pg8::EpiPle E{(const bf16*)(F.ws + WS_X2B_LO), (const bf16*)(F.ws + WS_X2B_HI), 8192, (const bf16*)(F.ws + WS_PP_LO), (const bf16*)(F.ws + WS_PP_HI), PP_ROW2, (const float*)(F.ws + WS_CTL + CT_SS3), (float*)(F.ws + WS_CTL + CT_SS4), EPS, (unsigned*)(F.ws + WS_CTL + CT_PCNT), F.in[16], F.out};
          pg8::gemm_phase<pg8::EpiPle, pg8::StaticOrder, true, true>(F.lds + RING_OFF, g, S, E); }
    }
    (void)ctl;
#undef IN
#undef SEAM
#undef LSEAM
}

extern "C" void kernel_launch(void* const* d_in, const int* in_sizes, int n_in, void* d_out, int out_size, void* d_ws, size_t ws_size, hipStream_t stream) {
    static int grid = 0;
    if (grid == 0) {
        if (n_in != 17 || in_sizes[0] != M * D || out_size != M * D || ws_size < WS_END) { fprintf(stderr, "kernel_launch: unexpected shapes (n_in %d, in0 %d, out %d, ws %zu); nothing launched\n", n_in, n_in > 0 ? in_sizes[0] : -1, out_size, ws_size); grid = -1; return; }
        int dev = 0, cus = 0, per_cu = 0;
        if (hipGetDevice(&dev) != hipSuccess || hipDeviceGetAttribute(&cus, hipDeviceAttributeMultiprocessorCount, dev) != hipSuccess) { grid = -1; return; }
        if (hipFuncSetAttribute((const void*)mk_fwd, hipFuncAttributeMaxDynamicSharedMemorySize, LDS_BYTES) != hipSuccess) { fprintf(stderr, "kernel_launch: hipFuncSetAttribute failed\n"); grid = -1; return; }
        if (hipOccupancyMaxActiveBlocksPerMultiprocessor(&per_cu, (const void*)mk_fwd, NWAVES * 64, LDS_BYTES) != hipSuccess || per_cu < 1) fprintf(stderr, "kernel_launch: note: occupancy query reports %d blocks per CU\n", per_cu);
        (void)hipGetLastError();
        grid = cus > 256 ? 256 : cus;
    }
    if (grid < 0) return;
    if (hipMemsetAsync((char*)d_ws + WS_CTL, 0, CTL_ZERO_BYTES, stream) != hipSuccess) { fprintf(stderr, "kernel_launch: memset failed\n"); return; }
    Args a{};
    for (int i = 0; i < 17; ++i) a.in[i] = (const float*)d_in[i];
    a.out = (float*)d_out; a.ws = (unsigned char*)d_ws;
    if (MK_N_LAUNCHES == 1) { a.ph_lo = 0; a.ph_hi = N_PHASES; hipLaunchKernelGGL(mk_fwd, dim3(grid), dim3(NWAVES * 64), LDS_BYTES, stream, a); }
    else for (int ph = 0; ph < N_PHASES; ++ph) { a.ph_lo = ph; a.ph_hi = ph + 1; hipLaunchKernelGGL(mk_fwd, dim3(grid), dim3(NWAVES * 64), LDS_BYTES, stream, a); }
}
```

```cpp
#include <hip/hip_runtime.h>
#include <cstdio>
#include <cstdint>
#include <cmath>
namespace pg8 {
#define PG8_LAS __attribute__((address_space(3)))
typedef unsigned short bf16_t;
typedef short bf16x8 __attribute__((ext_vector_type(8)));
typedef float f32x4 __attribute__((ext_vector_type(4)));
typedef unsigned u32x4 __attribute__((ext_vector_type(4)));
constexpr int BM = 256, BK = 64, HALF = 128, HTB = HALF * BK * 2  , STAGE_BYTES = 8 * HTB, NXCD = 8, WGM = 8;

__host__ __device__ __forceinline__ int lds_byte(int r, int c) { const int st = (r >> 4) * 2 + (c >> 5), rr = r & 15, cc = c & 31, ob = rr * 64 + cc * 2; return st * 1024 + (ob ^ (((ob >> 9) & 1) << 5)); }
__host__ __device__ __forceinline__ void stage_rc(int b, int& R, int& C) { const int st = b / 1024, sb = b % 1024, swz = sb ^ (((sb >> 9) & 1) << 5); R = (st >> 1) * 16 + swz / 64; C = (st & 1) * 32 + (swz % 64) / 2; }
__host__ __device__ __forceinline__ int perm32(int rho) { const int n = rho >> 4, i = rho & 15; return 8 * (i >> 2) + 4 * n + (i & 3); }

struct Unit { int pm, pn; };
struct Gemm { const bf16_t* A; const bf16_t* Bt; int M, N, K; const bf16_t* A2 = nullptr; int pm2 = 1 << 30; };

struct StaticOrder {
    int nM, nN, nwg, G, c;
    __host__ __device__ void init(int M, int N, int G_, int c_) { nM = M / BM; nN = N / BM; nwg = nM * nN; G = G_; c = c_; }
    __host__ __device__ bool next(int i, Unit& u) const {
        const long L = (long)i * G + c; if (L >= nwg) return false;
        int wgid = (int)L; { const int q = nwg / NXCD, r = nwg % NXCD, xcd = wgid % NXCD, off = wgid / NXCD; wgid = (xcd < r ? xcd * (q + 1) : r * (q + 1) + (xcd - r) * q) + off; }
        const int nig = WGM * nN, gid = wgid / nig, fm = gid * WGM, gsz = (nM - fm) < WGM ? (nM - fm) : WGM;
        u.pm = fm + ((wgid % nig) % gsz); u.pn = (wgid % nig) / gsz; return true;
    }
    __device__ __forceinline__ void a_ready(const Unit&) const {}
    __device__ __forceinline__ void done(const Unit&) const {}
};

__device__ __forceinline__ unsigned cvt_pk_bf16(float lo, float hi) { unsigned r; asm volatile("v_cvt_pk_bf16_f32 %0, %1, %2" : "=v"(r) : "v"(lo), "v"(hi)); return r; }
typedef float f32x2 __attribute__((ext_vector_type(2)));
__device__ __forceinline__ f32x2 gelu_pk(f32x2 v) {
    const f32x2 av = __builtin_elementwise_abs(v), d = av * 0.2316418882f + 1.0f;
    f32x2 t; t.x = __builtin_amdgcn_rcpf(d.x); t.y = __builtin_amdgcn_rcpf(d.y);
    f32x2 q = t * 0.5307027145f + (-0.7265760135f); q = q * t + 0.7107068705f; q = q * t + (-0.142248368f); q = q * t + 0.127414796f; q = q * t;
    const f32x2 s = (v * v) * (-0.72134752044f);
    f32x2 e; e.x = __builtin_amdgcn_exp2f(s.x); e.y = __builtin_amdgcn_exp2f(s.y);
    const f32x2 m = v * (q * e), r = v - m;
    f32x2 o; o.x = v.x < 0.f ? m.x : r.x; o.y = v.y < 0.f ? m.y : r.y; return o;
}

template <int ACT  > struct EpiBf16 {
    static constexpr bool PERM = true, AFTER_DRAIN = false; static_assert(ACT == 0 || ACT == 1, "EpiBf16: ACT is 0 (none) or 1 (gelu_pk)");
    bf16_t* O; int ldc; const float* bias; int split_cols; size_t split_stride; float scale0;
    __device__ __forceinline__ void operator()(const f32x4 (&acc)[2][2][4][2], const Unit& u, int wr, int wc, int fr, int fq) const {
        const int row0 = u.pm * BM + wr * 64 + fr; int colt = u.pn * BM; bf16_t* base = O;
        float sc = 1.f; if (split_cols) { const int t = colt / split_cols; base += (size_t)t * split_stride; colt -= t * split_cols; if (t == 0) sc = scale0; }
        const int col0 = colt + wc * 32 + 8 * fq, bcol0 = u.pn * BM + wc * 32 + 8 * fq;
        f32x4 bv[2][2];
#pragma unroll
        for (int bj = 0; bj < 2; ++bj)
#pragma unroll
            for (int n = 0; n < 2; ++n) bv[bj][n] = bias ? *(const f32x4*)(bias + bcol0 + bj * HALF + 4 * n) : (f32x4){0.f, 0.f, 0.f, 0.f};
#pragma unroll
        for (int ai = 0; ai < 2; ++ai)
#pragma unroll
            for (int m = 0; m < 4; ++m) { bf16_t* rowp = base + (size_t)(row0 + ai * HALF + m * 16) * ldc + col0;
#pragma unroll
                for (int bj = 0; bj < 2; ++bj) { f32x4 v0 = acc[ai][bj][m][0] + bv[bj][0], v1 = acc[ai][bj][m][1] + bv[bj][1];
                    if (ACT == 1) { f32x2 a = gelu_pk((f32x2){v0[0], v0[1]}), b = gelu_pk((f32x2){v0[2], v0[3]}), c = gelu_pk((f32x2){v1[0], v1[1]}), d = gelu_pk((f32x2){v1[2], v1[3]});
                        v0 = (f32x4){a.x, a.y, b.x, b.y}; v1 = (f32x4){c.x, c.y, d.x, d.y}; }
                    v0 = v0 * sc; v1 = v1 * sc; u32x4 w; w.x = cvt_pk_bf16(v0[0], v0[1]); w.y = cvt_pk_bf16(v0[2], v0[3]); w.z = cvt_pk_bf16(v1[0], v1[1]); w.w = cvt_pk_bf16(v1[2], v1[3]);
                    *(u32x4*)(rowp + bj * HALF) = w; } }
    }
};

__device__ __forceinline__ float sigm(float x) { return __builtin_amdgcn_rcpf(1.0f + __builtin_amdgcn_exp2f(-1.4426950408889634f * x)); }
__device__ __forceinline__ float gelu_t(float x) { return x * sigm(x * (1.5957691216057308f + 0.07135481627260025f * x * x)); }
__device__ __forceinline__ u32x4 pack8(const float (&o)[8]) { u32x4 w; w.x = cvt_pk_bf16(o[0], o[1]); w.y = cvt_pk_bf16(o[2], o[3]); w.z = cvt_pk_bf16(o[4], o[5]); w.w = cvt_pk_bf16(o[6], o[7]); return w; }
constexpr float QSCALE = 0.125f * 1.4426950408889634f;

struct EpiIn {
    static constexpr bool PERM = true, AFTER_DRAIN = false;
    bf16_t *UG, *VS, *Q, *K, *VA, *GB; float* stats1; float* kmean; unsigned* khmax; PG8_LAS unsigned char* stage;
    __device__ __forceinline__ void operator()(const f32x4 (&acc)[2][2][4][2], const Unit& u, int wr, int wc, int fr, int fq) const {
        const int row0 = u.pm * BM + wr * 64 + fr, cw = wc * 32 + 8 * fq;
        if (u.pn < 8) {
            bf16_t* base = UG + (size_t)row0 * 1024 + u.pn * 128 + cw;
#pragma unroll
            for (int ai = 0; ai < 2; ++ai)
#pragma unroll
                for (int m = 0; m < 4; ++m) { float o[8];
#pragma unroll
                    for (int n = 0; n < 2; ++n)
#pragma unroll
                        for (int j = 0; j < 4; ++j) o[4 * n + j] = gelu_t(acc[ai][0][m][n][j]) * sigm(acc[ai][1][m][n][j]);
                    *(u32x4*)(base + (size_t)(ai * HALF + m * 16) * 1024) = pack8(o); }
            return;
        }
        const int kind = (u.pn - 8) >> 2, ct = (u.pn - 8) & 3;
        bf16_t* base = (kind == 0 ? VS : kind == 1 ? Q : kind == 2 ? K : kind == 3 ? VA : GB) + (size_t)row0 * 1024 + ct * 256 + cw;
        if (kind == 0) {
#pragma unroll
            for (int ai = 0; ai < 2; ++ai)
#pragma unroll
                for (int m = 0; m < 4; ++m) { float s1 = 0.f, s2 = 0.f;
#pragma unroll
                    for (int bj = 0; bj < 2; ++bj) { float o[8];
#pragma unroll
                        for (int n = 0; n < 2; ++n)
#pragma unroll
                            for (int j = 0; j < 4; ++j) { const float g = gelu_t(acc[ai][bj][m][n][j]); o[4 * n + j] = g; s1 += g; s2 += g * g; }
                        *(u32x4*)(base + (size_t)(ai * HALF + m * 16) * 1024 + bj * HALF) = pack8(o); }
                    s1 += __shfl_xor(s1, 16); s1 += __shfl_xor(s1, 32); s2 += __shfl_xor(s2, 16); s2 += __shfl_xor(s2, 32);
                    if (fq == 0) { float* sp = stats1 + 2 * (size_t)(row0 + ai * HALF + m * 16); atomicAdd(sp, s1); atomicAdd(sp + 1, s2); } }
        } else if (kind == 2) {
            float mx[2] = {0.f, 0.f};
            bf16_t* kfb = K + ((size_t)((u.pm >> 5) * 16 + 4 * ct + (wc >> 1)) * 65536 + (size_t)(u.pm & 31) * 2048 + wr * 512 + (2 * (wc & 1) + (fq >> 1)) * 64 + (fq & 1) * 32 + fr) * 8;
#pragma unroll
            for (int ai = 0; ai < 2; ++ai)
#pragma unroll
                for (int m = 0; m < 4; ++m)
#pragma unroll
                    for (int bj = 0; bj < 2; ++bj) { float o[8]; float ss = 0.f;
#pragma unroll
                        for (int n = 0; n < 2; ++n)
#pragma unroll
                            for (int j = 0; j < 4; ++j) { const float v = acc[ai][bj][m][n][j]; o[4 * n + j] = v; ss += v * v; }
                        *(u32x4*)(kfb + (size_t)bj * (2 * 65536 * 8) + (ai * 1024 + (m >> 1) * 256 + (m & 1) * 16) * 8) = pack8(o);
                        ss += __shfl_xor(ss, 16); ss += __shfl_xor(ss, 32); mx[bj] = fmaxf(mx[bj], ss); }
            float* km = kmean + (size_t)u.pm * 1024 + ct * 256 + cw;
#pragma unroll
            for (int bj = 0; bj < 2; ++bj)
#pragma unroll
                for (int n = 0; n < 2; ++n)
#pragma unroll
                    for (int j = 0; j < 4; ++j) { float cs = 0.f;
#pragma unroll
                        for (int ai = 0; ai < 2; ++ai)
#pragma unroll
                            for (int m = 0; m < 4; ++m) cs += acc[ai][bj][m][n][j];
                        cs += __shfl_xor(cs, 1); cs += __shfl_xor(cs, 2); cs += __shfl_xor(cs, 4); cs += __shfl_xor(cs, 8);
                        if (fr == 0) atomicAdd(km + bj * HALF + 4 * n + j, cs); }
#pragma unroll
            for (int bj = 0; bj < 2; ++bj) { float v = mx[bj];
                v = fmaxf(v, __shfl_xor(v, 1)); v = fmaxf(v, __shfl_xor(v, 2)); v = fmaxf(v, __shfl_xor(v, 4)); v = fmaxf(v, __shfl_xor(v, 8));
                if (fr == 0 && fq == 0) atomicMax(khmax + (u.pm >> 5) * 32 + ct * 8 + bj * 4 + wc, __float_as_uint(sqrtf(v))); }
        } else if (kind == 3) {
            PG8_LAS unsigned char* stg = stage + (wr * 4 + wc) * 2304; const int lane = fq * 16 + fr;
            bf16_t* vfb = VA + ((size_t)((u.pm >> 5) * 16 + 4 * ct + (wc >> 1)) * 65536 + (size_t)(u.pm & 31) * 2048 + (2 * (wc & 1)) * 512 + (2 * wr + ((lane & 7) >> 2)) * 64 + (lane & 3) * 16 + 8 * ((lane >> 5) & 1) + ((lane >> 3) & 3)) * 8;
#pragma unroll
            for (int ai = 0; ai < 2; ++ai)
#pragma unroll
                for (int bj = 0; bj < 2; ++bj)
#pragma unroll
                    for (int n = 0; n < 2; ++n) {
#pragma unroll
                        for (int m = 0; m < 4; ++m)
#pragma unroll
                            for (int j = 0; j < 4; ++j) { const float lo = acc[ai][bj][m][n][j]; *(PG8_LAS bf16_t*)(stg + (4 * fq + j) * 144 + (16 * m + fr) * 2) = (bf16_t)(cvt_pk_bf16(lo, lo) & 0xffffu); }
                        asm volatile("s_waitcnt lgkmcnt(0)" ::: "memory");
                        const int trow = u.pm * BM + ai * HALF + wr * 64; const int bb = trow >> 13, t0 = trow & 8191;
#pragma unroll
                        for (int i = 0; i < 2; ++i) { const int id = lane + 64 * i, col = id >> 3, ch = id & 7;
                            const u32x4 v = *(const PG8_LAS u32x4*)(stg + col * 144 + ch * 16);
                            *(u32x4*)(vfb + (size_t)bj * (2 * 65536 * 8) + (ai * 256 + n * 4 + i * 512) * 8) = v; }
                        asm volatile("s_waitcnt lgkmcnt(0)" ::: "memory"); }
        } else {
#pragma unroll
            for (int ai = 0; ai < 2; ++ai)
#pragma unroll
                for (int m = 0; m < 4; ++m)
#pragma unroll
                    for (int bj = 0; bj < 2; ++bj) { float o[8];
#pragma unroll
                        for (int n = 0; n < 2; ++n)
#pragma unroll
                            for (int j = 0; j < 4; ++j) { const float v = acc[ai][bj][m][n][j]; o[4 * n + j] = kind == 1 ? v * QSCALE : kind == 4 ? sigm(v) : v; }
                        *(u32x4*)(base + (size_t)(ai * HALF + m * 16) * 1024 + bj * HALF) = pack8(o); }
        }
    }
};
template <bool BASE_BF16> struct EpiResid {
    static constexpr bool PERM = true, AFTER_DRAIN = false;
    const void* base; bf16_t* outb; float* ss; bf16_t* outb2; int row2;
    static constexpr int NB = BASE_BF16 ? 1 : 2;
    __device__ __forceinline__ void ld(u32x4 (&d)[2][NB], size_t off) const {
#pragma unroll
        for (int bj = 0; bj < 2; ++bj) {
            if (BASE_BF16) d[bj][0] = *(const u32x4*)((const bf16_t*)base + off + bj * HALF);
            else { d[bj][0] = *(const u32x4*)((const float*)base + off + bj * HALF); d[bj][NB - 1] = *(const u32x4*)((const float*)base + off + bj * HALF + 4); } }
    }
    __device__ __forceinline__ void operator()(const f32x4 (&acc)[2][2][4][2], const Unit& u, int wr, int wc, int fr, int fq) const {
        const int row0 = u.pm * BM + wr * 64 + fr, col0 = u.pn * BM + wc * 32 + 8 * fq;
        u32x4 pre[4][2][NB];
#pragma unroll
        for (int m = 0; m < 4; ++m) ld(pre[m], (size_t)(row0 + m * 16) * 1024 + col0);
#pragma unroll
        for (int ai = 0; ai < 2; ++ai)
#pragma unroll
            for (int m = 0; m < 4; ++m) { const int row = row0 + ai * HALF + m * 16; const size_t off = (size_t)row * 1024 + col0; float s = 0.f;
                u32x4 cur[2][NB];
#pragma unroll
                for (int bj = 0; bj < 2; ++bj)
#pragma unroll
                    for (int q = 0; q < NB; ++q) cur[bj][q] = pre[m][bj][q];
                if (ai == 0) ld(pre[m], off + (size_t)HALF * 1024);
#pragma unroll
                for (int bj = 0; bj < 2; ++bj) { f32x4 b0, b1;
                    if (BASE_BF16) { const u32x4 w = cur[bj][0];
                        b0 = (f32x4){__uint_as_float(w.x << 16), __uint_as_float(w.x & 0xffff0000u), __uint_as_float(w.y << 16), __uint_as_float(w.y & 0xffff0000u)};
                        b1 = (f32x4){__uint_as_float(w.z << 16), __uint_as_float(w.z & 0xffff0000u), __uint_as_float(w.w << 16), __uint_as_float(w.w & 0xffff0000u)}; }
                    else { b0 = __builtin_bit_cast(f32x4, cur[bj][0]); b1 = __builtin_bit_cast(f32x4, cur[bj][NB - 1]); }
                    const f32x4 v0 = acc[ai][bj][m][0] + b0, v1 = acc[ai][bj][m][1] + b1;
                    const float o[8] = {v0[0], v0[1], v0[2], v0[3], v1[0], v1[1], v1[2], v1[3]};
                    *(u32x4*)((row < row2 ? outb : outb2 - (size_t)row2 * 1024) + off + bj * HALF) = pack8(o);
#pragma unroll
                    for (int j = 0; j < 8; ++j) s += o[j] * o[j]; }
                s += __shfl_xor(s, 16); s += __shfl_xor(s, 32);
                if (fq == 0) atomicAdd(ss + row, s); }
    }
};
struct EpiFF1 {
    static constexpr bool PERM = true, AFTER_DRAIN = false;
    bf16_t* O; const float* ss; float eps;
    __device__ __forceinline__ void operator()(const f32x4 (&acc)[2][2][4][2], const Unit& u, int wr, int wc, int fr, int fq) const {
        const int row0 = u.pm * BM + wr * 64 + fr, col0 = u.pn * BM + wc * 32 + 8 * fq;
        float ssv[2][4];
#pragma unroll
        for (int ai = 0; ai < 2; ++ai)
#pragma unroll
            for (int m = 0; m < 4; ++m) ssv[ai][m] = ss[row0 + ai * HALF + m * 16];
#pragma unroll
        for (int ai = 0; ai < 2; ++ai)
#pragma unroll
            for (int m = 0; m < 4; ++m) { const int row = row0 + ai * HALF + m * 16; const float rs = 1.0f / sqrtf(ssv[ai][m] * (1.0f / 1024.0f) + eps);
#pragma unroll
                for (int bj = 0; bj < 2; ++bj) { float o[8];
#pragma unroll
                    for (int n = 0; n < 2; ++n)
#pragma unroll
                        for (int j = 0; j < 4; ++j) { const float v = fmaxf(acc[ai][bj][m][n][j] * rs, 0.f); o[4 * n + j] = v * v; }
                    *(u32x4*)(O + (size_t)row * 4096 + col0 + bj * HALF) = pack8(o); } }
    }
};
struct EpiStore {
    static constexpr bool PERM = true, AFTER_DRAIN = false;
    bf16_t* O_; bf16_t* O2; int row2;
    __device__ __forceinline__ void operator()(const f32x4 (&acc)[2][2][4][2], const Unit& u, int wr, int wc, int fr, int fq) const {
        const int row0 = u.pm * BM + wr * 64 + fr, col0 = u.pn * BM + wc * 32 + 8 * fq;
        bf16_t* O = u.pm * BM < row2 ? O_ : O2 - (size_t)row2 * 1024;
#pragma unroll
        for (int ai = 0; ai < 2; ++ai)
#pragma unroll
            for (int m = 0; m < 4; ++m)
#pragma unroll
                for (int bj = 0; bj < 2; ++bj) { float o[8];
#pragma unroll
                    for (int n = 0; n < 2; ++n)
#pragma unroll
                        for (int j = 0; j < 4; ++j) o[4 * n + j] = acc[ai][bj][m][n][j];
                    *(u32x4*)(O + (size_t)(row0 + ai * HALF + m * 16) * 1024 + col0 + bj * HALF) = pack8(o); }
    }
};
struct EpiPle {
    static constexpr bool PERM = true, AFTER_DRAIN = false;
    const bf16_t* X; const bf16_t* X2; int row2; const bf16_t* PP_; const bf16_t* PP2; int prow2; const float* ssin; float* ssout; float eps; unsigned* pcnt; const float* gf; float* out;
    __device__ __forceinline__ void operator()(const f32x4 (&acc_)[2][2][4][2], const Unit& u, int wr, int wc, int fr, int fq) const {
        f32x4 (&acc)[2][2][4][2] = const_cast<f32x4 (&)[2][2][4][2]>(acc_);
        const int row0 = u.pm * BM + wr * 64 + fr, col0 = u.pn * BM + wc * 32 + 8 * fq;
        const bf16_t* PP = u.pm * BM < prow2 ? PP_ : PP2 - (size_t)prow2 * 1024;
        constexpr int PD = 3;
        float ssv[2][4]; u32x4 xq[PD][2], pq[PD][2];
#pragma unroll
        for (int ai = 0; ai < 2; ++ai)
#pragma unroll
            for (int m = 0; m < 4; ++m) ssv[ai][m] = ssin[row0 + ai * HALF + m * 16];
#define PLE_LD(slot, it_) do { const int rn_ = row0 + ((it_) >> 2) * HALF + ((it_) & 3) * 16; const size_t offn_ = (size_t)rn_ * 1024 + col0; \
            _Pragma("unroll") for (int bj = 0; bj < 2; ++bj) { xq[slot][bj] = *(const u32x4*)((rn_ < row2 ? X : X2 - (size_t)row2 * 1024) + offn_ + bj * HALF); pq[slot][bj] = *(const u32x4*)(PP + offn_ + bj * HALF); } } while (0)
#pragma unroll
        for (int it = 0; it < PD; ++it) PLE_LD(it, it);
#pragma unroll
        for (int it = 0; it < 8; ++it) { const int ai = it >> 2, m = it & 3; const int row = row0 + ai * HALF + m * 16; const float rs = 1.0f / sqrtf(ssv[ai][m] * (1.0f / 1024.0f) + eps); float s = 0.f;
                u32x4 xc[2], pc[2];
#pragma unroll
                for (int bj = 0; bj < 2; ++bj) { xc[bj] = xq[it % PD][bj]; pc[bj] = pq[it % PD][bj]; }
                if (it + PD < 8) PLE_LD(it % PD, it + PD);
#pragma unroll
                for (int bj = 0; bj < 2; ++bj) { const u32x4 xw = xc[bj];
                    const f32x4 b0 = {__uint_as_float(xw.x << 16), __uint_as_float(xw.x & 0xffff0000u), __uint_as_float(xw.y << 16), __uint_as_float(xw.y & 0xffff0000u)};
                    const f32x4 b1 = {__uint_as_float(xw.z << 16), __uint_as_float(xw.z & 0xffff0000u), __uint_as_float(xw.w << 16), __uint_as_float(xw.w & 0xffff0000u)};
                    const u32x4 pw = pc[bj];
                    const float pp[8] = {__uint_as_float(pw.x << 16), __uint_as_float(pw.x & 0xffff0000u), __uint_as_float(pw.y << 16), __uint_as_float(pw.y & 0xffff0000u),
                                         __uint_as_float(pw.z << 16), __uint_as_float(pw.z & 0xffff0000u), __uint_as_float(pw.w << 16), __uint_as_float(pw.w & 0xffff0000u)};
                    f32x4 v0, v1;
#pragma unroll
                    for (int j = 0; j < 4; ++j) { v0[j] = b0[j] + sigm(acc[ai][bj][m][0][j] * rs) * pp[j]; v1[j] = b1[j] + sigm(acc[ai][bj][m][1][j] * rs) * pp[4 + j]; }
                    acc[ai][bj][m][0] = v0; acc[ai][bj][m][1] = v1;
#pragma unroll
                    for (int j = 0; j < 4; ++j) s += v0[j] * v0[j] + v1[j] * v1[j]; }
                s += __shfl_xor(s, 16); s += __shfl_xor(s, 32);
                if (fq == 0) atomicAdd(ssout + row, s); }
#undef PLE_LD
        asm volatile("s_waitcnt vmcnt(0)" ::: "memory"); __syncthreads();
        if (threadIdx.x == 0) { unsigned* c = pcnt + 64 * u.pm; __hip_atomic_fetch_add(c, 1u, __ATOMIC_RELAXED, __HIP_MEMORY_SCOPE_AGENT);
            unsigned sp = 0; while (__hip_atomic_load(c, __ATOMIC_RELAXED, __HIP_MEMORY_SCOPE_AGENT) < 4u) { __builtin_amdgcn_s_sleep(1); if (++sp > (1u << 22)) break; } }
        __syncthreads();
        float so[2][4]; f32x4 gq[2][2];
#pragma unroll
        for (int ai = 0; ai < 2; ++ai)
#pragma unroll
            for (int m = 0; m < 4; ++m) so[ai][m] = __hip_atomic_load(ssout + row0 + ai * HALF + m * 16, __ATOMIC_RELAXED, __HIP_MEMORY_SCOPE_AGENT);
#pragma unroll
        for (int bj = 0; bj < 2; ++bj) { gq[bj][0] = *(const f32x4*)(gf + col0 + bj * HALF); gq[bj][1] = *(const f32x4*)(gf + col0 + bj * HALF + 4); }
#pragma unroll
        for (int ai = 0; ai < 2; ++ai)
#pragma unroll
            for (int m = 0; m < 4; ++m) { const int row = row0 + ai * HALF + m * 16; const size_t off = (size_t)row * 1024 + col0;
                const float rs = 1.0f / sqrtf(so[ai][m] * (1.0f / 1024.0f) + eps);
#pragma unroll
                for (int bj = 0; bj < 2; ++bj) { *(f32x4*)(out + off + bj * HALF) = acc[ai][bj][m][0] * rs * gq[bj][0]; *(f32x4*)(out + off + bj * HALF + 4) = acc[ai][bj][m][1] * rs * gq[bj][1]; } }
    }
};

template <class Epi, class Sched, bool ALIGN_EPI = false, bool SP2 = false>
__device__ __forceinline__ void gemm_phase(PG8_LAS unsigned char* lds, const Gemm g, const Sched& S, const Epi& E) {
    int tid_ = threadIdx.x; asm volatile("" : "+v"(tid_));
    const int tid = tid_, wid = __builtin_amdgcn_readfirstlane(tid >> 6), lane = tid & 63, wr = wid >> 2, wc = wid & 3, fr = lane & 15, fq = lane >> 4;
    const int K = g.K, nt = K / BK;
    unsigned voffA[2], voffB[2];
#pragma unroll
    for (int i = 0; i < 2; ++i) { int R, C; stage_rc(tid * 16 + i * 8192, R, C); const int Rb = Epi::PERM ? ((R & ~31) + perm32(R & 31)) : R;
        voffA[i] = (unsigned)(R * K + C) * 2u; voffB[i] = (unsigned)(Rb * K + C) * 2u; }
    const size_t kstep = (size_t)(BK * 2);
    const size_t hstep = (size_t)HALF * K * 2;
    const size_t tstep = 2 * hstep;
    const unsigned ldsw = (unsigned)wid * 1024u;
    const int aoff = lds_byte(wr * 64 + fr, fq * 8), boff = lds_byte(wc * 32 + fr, fq * 8);
#define PG8_ABASE(pm_) ((pm_) < g.pm2 ? (const char*)g.A + (size_t)(pm_) * tstep : (const char*)g.A2 + (size_t)((pm_) - g.pm2) * tstep)
#define PG8_SA(b, h) (((b) * 2 + (h)) * HTB)
#define PG8_SB(b, h) ((4 + (b) * 2 + (h)) * HTB)
#define PG8_STAGE(bufoff, gbase, voff) do { _Pragma("unroll") for (int _i = 0; _i < 2; ++_i) \
        __builtin_amdgcn_global_load_lds((const unsigned*)((const char*)(gbase) + (voff)[_i]), (PG8_LAS unsigned*)(lds + (bufoff) + ldsw + _i * 8192), 16, 0, 0); } while (0)
#define PG8_LDA(dst, b, h) do { _Pragma("unroll") for (int m = 0; m < 4; ++m) _Pragma("unroll") for (int k = 0; k < 2; ++k) dst[m][k] = *(const PG8_LAS bf16x8*)(lds + PG8_SA(b, h) + aoff + m * 2048 + k * 1024); } while (0)
#define PG8_LDB(dst, b, h) do { _Pragma("unroll") for (int n = 0; n < 2; ++n) _Pragma("unroll") for (int k = 0; k < 2; ++k) dst[n][k] = *(const PG8_LAS bf16x8*)(lds + PG8_SB(b, h) + boff + n * 2048 + k * 1024); } while (0)
#define PG8_MMA(ai, bj, At, Bt) do { __builtin_amdgcn_s_setprio(1); _Pragma("unroll") for (int m = 0; m < 4; ++m) _Pragma("unroll") for (int n = 0; n < 2; ++n) _Pragma("unroll") for (int k = 0; k < 2; ++k) \
        acc[ai][bj][m][n] = __builtin_amdgcn_mfma_f32_16x16x32_bf16(Bt[n][k], At[m][k], acc[ai][bj][m][n], 0, 0, 0); __builtin_amdgcn_s_setprio(0); } while (0)
#define PG8_WAIT_V(n) asm volatile("s_waitcnt vmcnt(" #n ")" ::: "memory")
#define PG8_WAIT_L(n) asm volatile("s_waitcnt lgkmcnt(" #n ")" ::: "memory")
#define PG8_BAR __builtin_amdgcn_s_barrier()
#define PG8_SCHED __builtin_amdgcn_sched_barrier(0)
    Unit cur, nxt; int ui = 0;
    if (!S.next(0, cur)) return;
    f32x4 acc[2][2][4][2];
#pragma unroll
    for (int a = 0; a < 2; ++a)
#pragma unroll
        for (int b = 0; b < 2; ++b)
#pragma unroll
            for (int m = 0; m < 4; ++m)
#pragma unroll
                for (int n = 0; n < 2; ++n) acc[a][b][m][n] = (f32x4){0.f, 0.f, 0.f, 0.f};
    bf16x8 At[4][2], B0[2][2], B1[2][2];
    const char* cA = PG8_ABASE(cur.pm); const char* cB = (const char*)g.Bt + (size_t)cur.pn * tstep;
    S.a_ready(cur);
    if constexpr (SP2) {
        PG8_STAGE(PG8_SB(0, 0), cB, voffB); PG8_STAGE(PG8_SB(0, 1), cB + hstep, voffB); PG8_STAGE(PG8_SA(0, 0), cA, voffA); PG8_STAGE(PG8_SA(0, 1), cA + hstep, voffA);
        if (wr == 1) PG8_BAR;
        PG8_WAIT_V(2); PG8_BAR;
        PG8_STAGE(PG8_SB(1, 0), cB + kstep, voffB); PG8_STAGE(PG8_SA(1, 0), cA + kstep, voffA); PG8_STAGE(PG8_SB(1, 1), cB + hstep + kstep, voffB);
        PG8_WAIT_V(6); PG8_BAR;
    } else {
        PG8_STAGE(PG8_SB(0, 0), cB, voffB); PG8_STAGE(PG8_SA(0, 0), cA, voffA); PG8_STAGE(PG8_SB(0, 1), cB + hstep, voffB); PG8_STAGE(PG8_SA(0, 1), cA + hstep, voffA);
        if (wr == 1) PG8_BAR;
        PG8_WAIT_V(4); PG8_BAR;
        PG8_STAGE(PG8_SB(1, 0), cB + kstep, voffB); PG8_STAGE(PG8_SA(1, 0), cA + kstep, voffA); PG8_STAGE(PG8_SB(1, 1), cB + hstep + kstep, voffB);
        PG8_WAIT_V(6); PG8_BAR;
    }
    for (;;) {
        const bool has_next = S.next(ui + 1, nxt);
        const char* nA = has_next ? PG8_ABASE(nxt.pm) : cA; const char* nB = has_next ? (const char*)g.Bt + (size_t)nxt.pn * tstep : cB;
        for (int t = 0; t < nt; t += 2) {
            const bool last = (t == nt - 2);
            const char* a1 = cA + (size_t)(t + 1) * kstep;
            const char* a2 = last ? nA : cA + (size_t)(t + 2) * kstep; const char* b2 = last ? nB : cB + (size_t)(t + 2) * kstep;
            const char* a3 = a2 + kstep; const char* b3 = b2 + kstep;
            if (last && has_next) S.a_ready(nxt);
            if constexpr (SP2) {
            PG8_LDB(B0, 0, 0); PG8_LDB(B1, 0, 1); PG8_SCHED; PG8_LDA(At, 0, 0); PG8_STAGE(PG8_SA(1, 1), a1 + hstep, voffA);
            PG8_WAIT_V(8); PG8_WAIT_L(0); PG8_BAR; PG8_MMA(0, 0, At, B0); PG8_MMA(0, 1, At, B1); PG8_BAR; PG8_SCHED;
            PG8_LDA(At, 0, 1); PG8_STAGE(PG8_SB(0, 0), b2, voffB); PG8_STAGE(PG8_SB(0, 1), b2 + hstep, voffB); PG8_STAGE(PG8_SA(0, 0), a2, voffA);
            PG8_WAIT_V(8); PG8_WAIT_L(0); PG8_BAR; PG8_MMA(1, 0, At, B0); PG8_MMA(1, 1, At, B1); PG8_BAR; PG8_SCHED;
            PG8_LDB(B0, 1, 0); PG8_LDB(B1, 1, 1); PG8_SCHED; PG8_LDA(At, 1, 0); PG8_STAGE(PG8_SA(0, 1), a2 + hstep, voffA);
            PG8_WAIT_V(8); PG8_WAIT_L(0); PG8_BAR; PG8_MMA(0, 0, At, B0); PG8_MMA(0, 1, At, B1); PG8_BAR; PG8_SCHED;
            PG8_LDA(At, 1, 1); PG8_STAGE(PG8_SB(1, 0), b3, voffB); PG8_STAGE(PG8_SB(1, 1), b3 + hstep, voffB); PG8_STAGE(PG8_SA(1, 0), a3, voffA);
            PG8_WAIT_V(8); PG8_WAIT_L(0); PG8_BAR; PG8_MMA(1, 0, At, B0); PG8_MMA(1, 1, At, B1); PG8_BAR; PG8_SCHED;
            } else {
            PG8_LDB(B0, 0, 0); PG8_SCHED; PG8_LDA(At, 0, 0); PG8_STAGE(PG8_SA(1, 1), a1 + hstep, voffA);
            PG8_WAIT_L(8); PG8_BAR; PG8_WAIT_L(0); PG8_MMA(0, 0, At, B0); PG8_BAR; PG8_SCHED;
            PG8_LDB(B1, 0, 1); PG8_STAGE(PG8_SB(0, 0), b2, voffB);
            PG8_BAR; PG8_WAIT_L(0); PG8_MMA(0, 1, At, B1); PG8_BAR;
            PG8_LDA(At, 0, 1); PG8_STAGE(PG8_SA(0, 0), a2, voffA);
            PG8_BAR; PG8_WAIT_L(0); PG8_MMA(1, 0, At, B0); PG8_BAR; PG8_SCHED;
            PG8_STAGE(PG8_SB(0, 1), b2 + hstep, voffB);
            PG8_WAIT_V(6); PG8_BAR; PG8_MMA(1, 1, At, B1); PG8_BAR;
            PG8_LDB(B0, 1, 0); PG8_SCHED; PG8_LDA(At, 1, 0); PG8_STAGE(PG8_SA(0, 1), a2 + hstep, voffA);
            PG8_WAIT_L(8); PG8_BAR; PG8_WAIT_L(0); PG8_MMA(0, 0, At, B0); PG8_BAR; PG8_SCHED;
            PG8_LDB(B1, 1, 1); PG8_STAGE(PG8_SB(1, 0), b3, voffB);
            PG8_BAR; PG8_WAIT_L(0); PG8_MMA(0, 1, At, B1); PG8_BAR;
            PG8_LDA(At, 1, 1); PG8_STAGE(PG8_SA(1, 0), a3, voffA);
            PG8_BAR; PG8_WAIT_L(0); PG8_MMA(1, 0, At, B0); PG8_BAR; PG8_SCHED;
            PG8_STAGE(PG8_SB(1, 1), b3 + hstep, voffB);
            PG8_WAIT_V(6); PG8_BAR; PG8_MMA(1, 1, At, B1); PG8_BAR;
            }
        }
        if constexpr (ALIGN_EPI) { if (wr == 0) PG8_BAR; }
        if constexpr (!Epi::AFTER_DRAIN) { E(acc, cur, wr, wc, fr, fq); S.done(cur); }
        if (!has_next) break;
#pragma unroll
        for (int a = 0; a < 2; ++a)
#pragma unroll
            for (int b = 0; b < 2; ++b)
#pragma unroll
                for (int m = 0; m < 4; ++m)
#pragma unroll
                    for (int n = 0; n < 2; ++n) acc[a][b][m][n] = (f32x4){0.f, 0.f, 0.f, 0.f};
        cur = nxt; cA = nA; cB = nB; ++ui;
        if constexpr (ALIGN_EPI) { if (wr == 1) PG8_BAR; }
    }
    PG8_WAIT_V(0);
    if constexpr (!ALIGN_EPI) { if (wr == 0) PG8_BAR; }
    PG8_BAR;
    if constexpr (Epi::AFTER_DRAIN) { E.fused(acc, cur, wr, wc, fr, fq, lds, wid, lane); S.done(cur); }
#undef PG8_ABASE
#undef PG8_SA
#undef PG8_SB
#undef PG8_STAGE
#undef PG8_LDA
#undef PG8_LDB
#undef PG8_MMA
#undef PG8_WAIT_V
#undef PG8_WAIT_L
#undef PG8_BAR
#undef PG8_SCHED
}
}
#define GAS __attribute__((address_space(1)))
#define LAS __attribute__((address_space(3)))
typedef unsigned short bf16;
typedef unsigned v4u __attribute__((ext_vector_type(4)));
typedef float f32x4 __attribute__((ext_vector_type(4)));
typedef short bf16x8 __attribute__((ext_vector_type(8)));
typedef GAS unsigned gu32;
typedef GAS unsigned long long gu64;
#define RLX_AGENT __ATOMIC_RELAXED, __HIP_MEMORY_SCOPE_AGENT
#define LDS_WAIT() asm volatile("s_waitcnt lgkmcnt(0)" ::: "memory")
#define VM_WAIT() asm volatile("s_waitcnt vmcnt(0)" ::: "memory")
__device__ __forceinline__ unsigned long long rt() { return __builtin_amdgcn_s_memrealtime(); }
__device__ __forceinline__ unsigned f2bf(float f) { unsigned u = __builtin_bit_cast(unsigned, f); return (u + 0x7fffu + ((u >> 16) & 1u)) >> 16; }
__device__ __forceinline__ unsigned pk2(float lo, float hi) { return f2bf(lo) | (f2bf(hi) << 16); }

#define XB_TMO      128
#define XB_XCNT(j)  (256  + 64 * (j))
#define XB_XSUB(j)  (1280 + 64 * (j))
#define XB_XGEN(j)  (2304 + 64 * (j))
#define XB_TOP      3328
#define XB_TOPGEN   3392
#define XCD_BAR_WORDS 3456
#define XB_GSUB(j)  (3520 + 64 * (j))
#define XB_GGEN(j)  (4096 + 64 * (j))
#define XB_XID      4672
#define XB_QSUB(q)  (8192 + 64 * (q))
#define XB_QGEN(q)  (12288 + 64 * (q))
#define BARW_TOTAL  16384
#define XB_SPIN_CAP (1u << 22)

__device__ __forceinline__ unsigned xb_ld(unsigned* p)              { return __hip_atomic_load(p, __ATOMIC_RELAXED, __HIP_MEMORY_SCOPE_AGENT); }
__device__ __forceinline__ unsigned xb_add(unsigned* p, unsigned v) { return __hip_atomic_fetch_add(p, v, __ATOMIC_RELAXED, __HIP_MEMORY_SCOPE_AGENT); }
__device__ __forceinline__ unsigned xb_xcc_id() { return (unsigned)__builtin_amdgcn_s_getreg((3 << 11) | 20) & 0xFu; }
#define XB_SPIN(cond, bar) do { unsigned _sp = 0; while (cond) { __builtin_amdgcn_s_sleep(1); \
    if ((++_sp & 255u) == 0u) { if (xb_ld(&(bar)[XB_TMO])) break; if (_sp > XB_SPIN_CAP) { atomicAdd(&(bar)[XB_TMO], 1u); break; } } } } while (0)

struct XcdBarrier {
    unsigned* bar; unsigned x;
    volatile LAS unsigned* st;
};

__device__ __forceinline__ XcdBarrier xcd_barrier_post(unsigned* bar, volatile LAS unsigned* st) {
    XcdBarrier b; b.bar = bar; b.x = xb_xcc_id(); b.st = st;
    if (threadIdx.x == 0) { (void)xb_add(&bar[XB_XCNT(b.x)], 1u); if (blockIdx.x < 256) __hip_atomic_store(&bar[XB_XID + blockIdx.x], b.x + 1u, __ATOMIC_RELAXED, __HIP_MEMORY_SCOPE_AGENT); }
    return b;
}
__device__ __forceinline__ void xcd_barrier_complete(unsigned* bar, unsigned x, unsigned& nloc, unsigned& nx) {
    const unsigned G = gridDim.x * gridDim.y * gridDim.z;
    unsigned sum, cnt, mine, sp = 0u;
    for (;;) {
        sum = 0u; cnt = 0u; mine = 0u;
#pragma unroll
        for (unsigned j = 0; j < 16; ++j) { const unsigned c = xb_ld(&bar[XB_XCNT(j)]); sum += c; cnt += (c > 0u) ? 1u : 0u; mine = (j == x) ? c : mine; }
        if (sum == G) break;
        __builtin_amdgcn_s_sleep(1);
        if ((++sp & 255u) == 0u) { if (xb_ld(&bar[XB_TMO])) break; if (sp > XB_SPIN_CAP) { atomicAdd(&bar[XB_TMO], 1u); break; } }
    }
    nloc = mine > 0u ? mine : 1u; nx = cnt > 0u ? cnt : 1u;
}

__device__ __forceinline__ void xcd_barrier(const XcdBarrier& b) {
    asm volatile("s_waitcnt vmcnt(0)" ::: "memory");
    __syncthreads();
    if (threadIdx.x == 0) {
        unsigned* bar = b.bar;
        __builtin_amdgcn_s_waitcnt(0);
        unsigned nloc = b.st[0], nx = b.st[1];
        if (nloc == 0u) { xcd_barrier_complete(bar, b.x, nloc, nx); b.st[0] = nloc; b.st[1] = nx; }
        const unsigned old = xb_add(&bar[XB_XSUB(b.x)], 1u);
        const unsigned gen = old / nloc;
        if (old + 1u == (gen + 1u) * nloc) {
            __builtin_amdgcn_fence(__ATOMIC_RELEASE, "agent");
            asm volatile("s_waitcnt vmcnt(0)" ::: "memory");
            const unsigned og = xb_add(&bar[XB_TOP], 1u);
            const unsigned tg = og / nx;
            if (og + 1u == (tg + 1u) * nx) xb_add(&bar[XB_TOPGEN], 1u);
            else XB_SPIN(xb_ld(&bar[XB_TOPGEN]) == tg, bar);
            __builtin_amdgcn_fence(__ATOMIC_ACQUIRE, "agent");
            xb_add(&bar[XB_XGEN(b.x)], 1u);
            asm volatile("s_waitcnt vmcnt(0)" ::: "memory");
        } else {
            XB_SPIN(xb_ld(&bar[XB_XGEN(b.x)]) == gen, bar);
            __builtin_amdgcn_fence(__ATOMIC_ACQUIRE, "agent");
            asm volatile("s_waitcnt vmcnt(0)" ::: "memory");
        }
    }
    __syncthreads();
}

__device__ __forceinline__ bool grp_local_ok(const XcdBarrier& b, volatile LAS unsigned* flag) {
    if (threadIdx.x == 0) *flag = 1u;
    __syncthreads();
    if (gridDim.x != 256) { if (threadIdx.x == 0) *flag = 0u; }
    else if (threadIdx.x < 256) { const unsigned mine = xb_ld(&b.bar[XB_XID + threadIdx.x]), first = xb_ld(&b.bar[XB_XID + (threadIdx.x & 7)]); if (mine != first || mine == 0u) *flag = 0u; }
    __syncthreads();
    return *flag != 0u;
}
__device__ __forceinline__ void quad_barrier(const XcdBarrier& b, unsigned q) {
    asm volatile("s_waitcnt vmcnt(0)" ::: "memory");
    __syncthreads();
    if (threadIdx.x == 0) {
        unsigned* bar = b.bar;
        const unsigned old = xb_add(&bar[XB_QSUB(q)], 1u), gen = old / 4u;
        if (old + 1u == (gen + 1u) * 4u) xb_add(&bar[XB_QGEN(q)], 1u);
        else XB_SPIN(xb_ld(&bar[XB_QGEN(q)]) == gen, bar);
        __builtin_amdgcn_fence(__ATOMIC_ACQUIRE, "agent");
        asm volatile("s_waitcnt vmcnt(0)" ::: "memory");
    }
    __syncthreads();
}
__device__ __forceinline__ void grp_barrier(const XcdBarrier& b, unsigned g) {
    asm volatile("s_waitcnt vmcnt(0)" ::: "memory");
    __syncthreads();
    if (threadIdx.x == 0) {
        unsigned* bar = b.bar;
        const unsigned old = xb_add(&bar[XB_GSUB(g)], 1u), gen = old / 32u;
        if (old + 1u == (gen + 1u) * 32u) xb_add(&bar[XB_GGEN(g)], 1u);
        else XB_SPIN(xb_ld(&bar[XB_GGEN(g)]) == gen, bar);
        __builtin_amdgcn_fence(__ATOMIC_ACQUIRE, "agent");
        asm volatile("s_waitcnt vmcnt(0)" ::: "memory");
    }
    __syncthreads();
}

__device__ unsigned g_boot_gc[8 * 64], g_boot_tc[64], g_boot_ts[64];
__device__ __forceinline__ unsigned boot_arrive(unsigned* barw) {
    const unsigned G = gridDim.x;
    for (unsigned i = blockIdx.x * blockDim.x + threadIdx.x; i < (unsigned)BARW_TOTAL; i += G * blockDim.x) __hip_atomic_store(&barw[i], 0u, __ATOMIC_RELAXED, __HIP_MEMORY_SCOPE_AGENT);
    asm volatile("s_waitcnt vmcnt(0)" ::: "memory");
    __syncthreads();
    unsigned ts0 = 0u;
    if (threadIdx.x == 0) {
        const unsigned g = blockIdx.x & 7u, gsz = (G + 7u - g) / 8u, ng = G < 8u ? G : 8u;
        ts0 = xb_ld(&g_boot_ts[0]);
        if (xb_add(&g_boot_gc[g * 64], 1u) + 1u == gsz) {
            __hip_atomic_store(&g_boot_gc[g * 64], 0u, __ATOMIC_RELAXED, __HIP_MEMORY_SCOPE_AGENT);
            if (xb_add(&g_boot_tc[0], 1u) + 1u == ng) { __hip_atomic_store(&g_boot_tc[0], 0u, __ATOMIC_RELAXED, __HIP_MEMORY_SCOPE_AGENT); __hip_atomic_store(&g_boot_ts[0], ts0 ^ 1u, __ATOMIC_RELEASE, __HIP_MEMORY_SCOPE_AGENT); } }
    }
    return ts0;
}
__device__ __forceinline__ void boot_wait(unsigned ts0) {
    if (threadIdx.x == 0) { unsigned sp = 0u; while (xb_ld(&g_boot_ts[0]) == ts0) { __builtin_amdgcn_s_sleep(1); if (++sp > XB_SPIN_CAP) break; } }
    __syncthreads();
}

constexpr int NWAVES = 8;
constexpr int BATCH = 2, SEQ = 8192, D = 1024, H = 16, HD = 64, FF = 4096, PLE = 256, NIN = 7168;
constexpr int M = BATCH * SEQ;
constexpr float EPS = 1e-6f;
constexpr float LOG2E = 1.4426950408889634f;

constexpr size_t MiB = 1u << 20, KiB = 1u << 10;
constexpr size_t WS_CTL = 0, CTL_ZERO_BYTES = 1 * MiB;
constexpr size_t CT_STATS1 = 0;
constexpr size_t CT_SS2 = 128 * KiB, CT_SS3 = 192 * KiB, CT_SS4 = 256 * KiB;
constexpr size_t CT_KMEAN = 320 * KiB;
constexpr size_t CT_KHMAX = 576 * KiB;
constexpr size_t CT_PCNT = 600 * KiB;
constexpr size_t CT_BAR = 640 * KiB;
constexpr size_t WS_WIN = 1 * MiB, WS_WOUT = 15 * MiB, WS_W1 = 17 * MiB, WS_W2 = 25 * MiB, WS_WG = 33 * MiB, WS_WP = 35 * MiB;
constexpr size_t WS_WM = 35 * MiB + 512 * KiB, WS_LUT = 35 * MiB + 768 * KiB;
constexpr size_t WS_Q = 36 * MiB, WS_K = 68 * MiB, WS_UG = 100 * MiB, WS_VS = 132 * MiB, WS_VA = 164 * MiB, WS_GB = 196 * MiB, WS_PB = 228 * MiB;
constexpr size_t WS_X1 = 36 * MiB;
constexpr size_t WS_A = 100 * MiB;
constexpr size_t WS_X2B_LO = 36 * MiB, WS_X2B_HI = 52 * MiB;
constexpr size_t WS_PP_LO = 1 * MiB, WS_PP_HI = 236 * MiB; constexpr int PP_ROW2 = 7168;
constexpr size_t CT_DONE3 = 624 * KiB;
constexpr size_t WS_END = 256 * MiB;

constexpr int RING_OFF = 0, RING_BYTES = 131072;
constexpr int LDSCTL_OFF = 156816, MISC_OFF = LDSCTL_OFF + 320;
constexpr int LDS_BYTES = 159744;

struct Frame {
    LAS unsigned char* lds;
    volatile LAS unsigned* MISC;
    unsigned char* ws;
    int tid, lane, wave, vcu, G;
    const float* in[17];
    float* out;
};

__device__ __forceinline__ float wave_sum(float v) {
#pragma unroll
    for (int o = 1; o < 64; o <<= 1) v += __shfl_xor(v, o);
    return v;
}
__device__ __forceinline__ float wave_max(float v) {
#pragma unroll
    for (int o = 1; o < 64; o <<= 1) v = fmaxf(v, __shfl_xor(v, o));
    return v;
}
__device__ __forceinline__ int wave_min_i(int v) {
#pragma unroll
    for (int o = 1; o < 64; o <<= 1) { const int t = __shfl_xor(v, o); v = t < v ? t : v; }
    return v;
}
__device__ __forceinline__ float bflo(unsigned w) { return __uint_as_float(w << 16); }
__device__ __forceinline__ float bfhi(unsigned w) { return __uint_as_float(w & 0xffff0000u); }

__device__ __forceinline__ int win_rowmap(int c) {
    if (c < 1024) return (c >> 7) * 256 + (c & 127);
    if (c < 5120) return c + 1024;
    if (c < 6144) { const int d = c - 5120; return (d >> 7) * 256 + 128 + (d & 127); }
    return c;
}
__device__ __forceinline__ void p0_transpose_item(const float* W, int K, int N, bf16* WT, int dst_row0, int k0, int n0, const float* gk, LAS float* scr, int lane) {
#pragma unroll 8
    for (int i = 0; i < 32; ++i) { const int kk = 2 * i + (lane >> 5); scr[kk * 33 + (lane & 31)] = W[(size_t)(k0 + kk) * N + n0 + (lane & 31)]; }
    LDS_WAIT(); asm volatile("" ::: "memory");
    const int c = lane & 7;
    float g[8];
#pragma unroll
    for (int e = 0; e < 8; ++e) g[e] = gk ? gk[k0 + 8 * c + e] : 1.0f;
#pragma unroll
    for (int j = 0; j < 4; ++j) { const int n = (lane >> 3) + 8 * j; const LAS float* s = scr + (8 * c) * 33 + n;
        v4u o; o.x = pk2(s[0 * 33] * g[0], s[1 * 33] * g[1]); o.y = pk2(s[2 * 33] * g[2], s[3 * 33] * g[3]); o.z = pk2(s[4 * 33] * g[4], s[5 * 33] * g[5]); o.w = pk2(s[6 * 33] * g[6], s[7 * 33] * g[7]);
        *(GAS v4u*)(WT + (size_t)(dst_row0 + n) * K + k0 + 8 * c) = o; }
    LDS_WAIT(); asm volatile("" ::: "memory");
}
__device__ __forceinline__ int rel_bucket(int n) {
    if (n < 16) return n;
    int b = 16;
    b += (n >= 21); b += (n >= 27); b += (n >= 35); b += (n >= 46); b += (n >= 59); b += (n >= 77); b += (n >= 99); b += (n >= 128);
    b += (n >= 166); b += (n >= 216); b += (n >= 280); b += (n >= 363); b += (n >= 470); b += (n >= 609); b += (n >= 790);
    return b;
}
__device__ __forceinline__ void p0_prologue(Frame& F, const int part) {
    LAS float* scr = (LAS float*)(F.lds + RING_OFF + F.wave * 16384);
    const int gw = F.vcu * NWAVES + F.wave, NGW = F.G * NWAVES;
    const float *x = F.in[0], *p = F.in[1], *g_mix = F.in[2], *w_in = F.in[3], *w_s = F.in[4], *rel = F.in[8], *w_out = F.in[9], *g_ffn = F.in[10], *w1 = F.in[11], *w2 = F.in[12], *g_ple = F.in[13], *wg = F.in[14], *wp = F.in[15];
    bf16 *Win_t = (bf16*)(F.ws + WS_WIN), *Wout_t = (bf16*)(F.ws + WS_WOUT), *W1_t = (bf16*)(F.ws + WS_W1), *W2_t = (bf16*)(F.ws + WS_W2), *Wg_t = (bf16*)(F.ws + WS_WG), *Wp_t = (bf16*)(F.ws + WS_WP);
    constexpr int I_IN = (D / 64) * (NIN / 32), I_OUT = (D / 64) * (D / 32), I_1 = (D / 64) * (FF / 32), I_2 = (FF / 64) * (D / 32), I_G = I_OUT, I_P = (PLE / 64) * (D / 32);
    constexpr int NITEMS = I_IN + I_OUT + I_1 + I_2 + I_G + I_P;
    for (int it = (part == 0 ? gw : I_IN + gw); it < (part == 0 ? I_IN : NITEMS); it += NGW) {
        int r = it;
        if (r < I_IN) { const int nb = r % (NIN / 32), kb = r / (NIN / 32); p0_transpose_item(w_in, D, NIN, Win_t, win_rowmap(32 * nb), 64 * kb, 32 * nb, nullptr, scr, F.lane); continue; } r -= I_IN;
        if (r < I_OUT) { const int nb = r % (D / 32), kb = r / (D / 32); p0_transpose_item(w_out, D, D, Wout_t, 32 * nb, 64 * kb, 32 * nb, nullptr, scr, F.lane); continue; } r -= I_OUT;
        if (r < I_1) { const int nb = r % (FF / 32), kb = r / (FF / 32); p0_transpose_item(w1, D, FF, W1_t, 32 * nb, 64 * kb, 32 * nb, g_ffn, scr, F.lane); continue; } r -= I_1;
        if (r < I_2) { const int nb = r % (D / 32), kb = r / (D / 32); p0_transpose_item(w2, FF, D, W2_t, 32 * nb, 64 * kb, 32 * nb, nullptr, scr, F.lane); continue; } r -= I_2;
        if (r < I_G) { const int nb = r % (D / 32), kb = r / (D / 32); p0_transpose_item(wg, D, D, Wg_t, 32 * nb, 64 * kb, 32 * nb, g_ple, scr, F.lane); continue; } r -= I_G;
        { const int nb = r % (D / 32), kb = r / (D / 32); p0_transpose_item(wp, PLE, D, Wp_t, 32 * nb, 64 * kb, 32 * nb, nullptr, scr, F.lane); }
    }
    const int gt = F.vcu * (NWAVES * 64) + F.tid, NGT = F.G * NWAVES * 64;
    if (part == 0) { bf16* Wm = (bf16*)(F.ws + WS_WM);
      for (int i = gt; i < 8 * 128 * 128; i += NGT) { const int s = i & 127, t = (i >> 7) & 127, g = i >> 14;
        Wm[((((g * 4 + (t >> 5)) * 8 + (s >> 4)) * 64 + ((s >> 3) & 1) * 32 + (t & 31)) << 3) + (s & 7)] = (bf16)f2bf(s <= t ? w_s[i] : 0.f); } }
    if (part == 0) { float* lut = (float*)(F.ws + WS_LUT);
      for (int i = gt; i < 16 * 1024; i += NGT) { const int h = i >> 10, dist = i & 1023; lut[i] = rel[rel_bucket(dist) * 16 + h] * LOG2E; }
      if (gt < 16) { float mb = -INFINITY; for (int k = 0; k < 32; ++k) mb = fmaxf(mb, rel[k * 16 + gt]); lut[16 * 1024 + gt] = mb * LOG2E; } }
    if (part == 1) { bf16* Pb = (bf16*)(F.ws + WS_PB);
      for (int i = gt; i < M * PLE / 8; i += NGT) { const f32x4 a = ((const f32x4*)p)[2 * i], b = ((const f32x4*)p)[2 * i + 1];
        v4u o; o.x = pk2(a.x, a.y); o.y = pk2(a.z, a.w); o.z = pk2(b.x, b.y); o.w = pk2(b.z, b.w); ((v4u*)Pb)[i] = o; } }
    if (part == 0) { bf16* Hn = (bf16*)F.out;
      f32x4 gv[4];
#pragma unroll
      for (int j = 0; j < 4; ++j) gv[j] = ((const f32x4*)g_mix)[F.lane + 64 * j];
      for (int m = gw; m < M; m += NGW) { const f32x4* xr = (const f32x4*)(x + (size_t)m * D) + F.lane; f32x4 v[4]; float s = 0.f;
#pragma unroll
        for (int j = 0; j < 4; ++j) { v[j] = xr[64 * j]; s += (v[j].x * v[j].x + v[j].y * v[j].y) + (v[j].z * v[j].z + v[j].w * v[j].w); }
        const float rs = 1.0f / sqrtf(wave_sum(s) * (1.0f / D) + EPS);
        unsigned long long* o8 = (unsigned long long*)(Hn + (size_t)m * D) + F.lane;
#pragma unroll
        for (int j = 0; j < 4; ++j) o8[64 * j] = (unsigned long long)pk2(v[j].x * rs * gv[j].x, v[j].y * rs * gv[j].y) | ((unsigned long long)pk2(v[j].z * rs * gv[j].z, v[j].w * rs * gv[j].w) << 32); } }
}

__device__ __forceinline__ void attn_simple(Frame& F) {
    LAS float* pbuf = (LAS float*)(F.lds + RING_OFF) + F.wave * 1024;
    const int gw = F.vcu * NWAVES + F.wave, NGW = F.G * NWAVES, lane = F.lane;
    const bf16 *Q = (const bf16*)(F.ws + WS_Q), *K = (const bf16*)(F.ws + WS_K), *VA = (const bf16*)(F.ws + WS_VA);
    const float *kmean = (const float*)(F.ws + WS_CTL + CT_KMEAN), *lut = (const float*)(F.ws + WS_LUT);
    bf16* YB = (bf16*)((unsigned char*)F.out + 32 * MiB);
    for (int item = gw; item < BATCH * H * SEQ; item += NGW) {
        const int t = item & (SEQ - 1), bh = item >> 13, b = bh >> 4, h = bh & 15, own = t >> 8;
        const size_t rowq = (size_t)b * SEQ + t;
        float q[64];
        { const v4u* qp = (const v4u*)(Q + rowq * D + h * HD);
#pragma unroll
          for (int i = 0; i < 8; ++i) { const v4u w = qp[i]; q[8 * i] = bflo(w.x); q[8 * i + 1] = bfhi(w.x); q[8 * i + 2] = bflo(w.y); q[8 * i + 3] = bfhi(w.y); q[8 * i + 4] = bflo(w.z); q[8 * i + 5] = bfhi(w.z); q[8 * i + 6] = bflo(w.w); q[8 * i + 7] = bfhi(w.w); } }
        float g = -INFINITY;
        if (lane < own) { const f32x4* km = (const f32x4*)(kmean + (size_t)(b * 32 + lane) * D + h * HD); float a = 0.f;
#pragma unroll
            for (int i = 0; i < 16; ++i) { const f32x4 kv = km[i]; a += q[4 * i] * kv.x + q[4 * i + 1] * kv.y + q[4 * i + 2] * kv.z + q[4 * i + 3] * kv.w; }
            g = a; }
        int sel[3];
#pragma unroll
        for (int r = 0; r < 3; ++r) { const float mg = wave_max(g); int idx = (g == mg && mg > -INFINITY) ? lane : 64; idx = wave_min_i(idx); sel[r] = idx; if (lane == idx) g = -INFINITY; }
        float sv[4][4]; float mx = -INFINITY;
#pragma unroll
        for (int blk = 0; blk < 4; ++blk) { const int n = blk < 3 ? sel[blk] : own;
#pragma unroll
            for (int kg = 0; kg < 4; ++kg) { float s = -INFINITY;
                if (n < 64) { const int kpos = n * 256 + kg * 64 + lane; const v4u* kp = (const v4u*)(K + ((size_t)b * SEQ + kpos) * D + h * HD); float a = 0.f;
#pragma unroll
                    for (int i = 0; i < 8; ++i) { const v4u w = kp[i]; a += q[8 * i] * bflo(w.x) + q[8 * i + 1] * bfhi(w.x) + q[8 * i + 2] * bflo(w.y) + q[8 * i + 3] * bfhi(w.y) + q[8 * i + 4] * bflo(w.z) + q[8 * i + 5] * bfhi(w.z) + q[8 * i + 6] * bflo(w.w) + q[8 * i + 7] * bfhi(w.w); }
                    const int dist = t - kpos; if (dist >= 0) s = a + lut[h * 1024 + (dist < 1023 ? dist : 1023)]; }
                sv[blk][kg] = s; mx = fmaxf(mx, s); } }
        mx = wave_max(mx);
        float l = 0.f;
#pragma unroll
        for (int blk = 0; blk < 4; ++blk)
#pragma unroll
            for (int kg = 0; kg < 4; ++kg) { const float pe = __builtin_amdgcn_exp2f(sv[blk][kg] - mx); l += pe; pbuf[blk * 256 + kg * 64 + lane] = pe; }
        l = wave_sum(l);
        LDS_WAIT(); asm volatile("" ::: "memory");
        float o = 0.f;
#pragma unroll
        for (int blk = 0; blk < 4; ++blk) { const int n = blk < 3 ? sel[blk] : own;
            if (n < 64) { const bf16* vp = VA + ((size_t)b * SEQ + n * 256) * D + h * HD + lane;
#pragma unroll 8
                for (int key = 0; key < 256; ++key) o += pbuf[blk * 256 + key] * __uint_as_float((unsigned)vp[(size_t)key * D] << 16); } }
        YB[rowq * D + h * HD + lane] = (bf16)f2bf(o / l);
        LDS_WAIT(); asm volatile("" ::: "memory");
    }
}
__device__ __forceinline__ void sgu_simple(Frame& F) {
    LAS float* vn = (LAS float*)(F.lds + RING_OFF);
    const bf16 *UG = (const bf16*)(F.ws + WS_UG), *VS = (const bf16*)(F.ws + WS_VS), *GB = (const bf16*)(F.ws + WS_GB), *YB = (const bf16*)((unsigned char*)F.out + 32 * MiB);
    bf16* MG = (bf16*)F.out;
    const float *stats = (const float*)(F.ws + WS_CTL + CT_STATS1), *w_s = F.in[4], *b_s = F.in[5], *lng = F.in[6], *lnb = F.in[7];
    const int ch = F.tid & 255, th = __builtin_amdgcn_readfirstlane(F.tid >> 8);
    for (int item = F.vcu; item < (M / 128) * 4; item += F.G) {
        const int c = item >> 2, qd = item & 3, col = 256 * qd + ch;
        __syncthreads();
        { const float lg = lng[col], lb = lnb[col];
          for (int s = th; s < 128; s += 2) { const size_t row = (size_t)c * 128 + s; const float s1 = stats[2 * row], s2 = stats[2 * row + 1];
            const float mu = s1 * (1.0f / 1024.0f), var = fmaxf(s2 * (1.0f / 1024.0f) - mu * mu, 0.f), rs = 1.0f / sqrtf(var + EPS);
            vn[s * 256 + ch] = (__uint_as_float((unsigned)VS[row * D + col] << 16) - mu) * rs * lg + lb; } }
        __syncthreads();
        const int g = __builtin_amdgcn_readfirstlane(col >> 7);
        for (int tt = 0; tt < 64; ++tt) { const int t = 64 * th + tt; const float* wr_ = w_s + ((size_t)g * 128 + t) * 128; float a = 0.f;
            for (int s = 0; s <= t; ++s) a += wr_[s] * vn[s * 256 + ch];
            const float mixed = a + b_s[g * 128 + t];
            const size_t off = ((size_t)c * 128 + t) * D + col;
            const float ug = __uint_as_float((unsigned)UG[off] << 16), gb = __uint_as_float((unsigned)GB[off] << 16), yb = __uint_as_float((unsigned)YB[off] << 16);
            MG[off] = (bf16)f2bf(ug * mixed + gb * yb); }
    }
    __syncthreads();
}

typedef short v4i16_t __attribute__((ext_vector_type(4)));
typedef unsigned u32x4_t __attribute__((ext_vector_type(4)));
typedef float f32x16 __attribute__((ext_vector_type(16)));
typedef LAS const unsigned char* lds_cptr;
__device__ __forceinline__ v4i16_t vtr(lds_cptr p) { return __builtin_amdgcn_ds_read_tr16_b64_v4i16((LAS v4i16_t*)p); }
__device__ __forceinline__ bf16x8 cat8(v4i16_t a, v4i16_t b) { return (bf16x8){a[0], a[1], a[2], a[3], b[0], b[1], b[2], b[3]}; }
__device__ __forceinline__ unsigned cvtpk(float lo, float hi) { unsigned r; asm("v_cvt_pk_bf16_f32 %0, %1, %2" : "=v"(r) : "v"(lo), "v"(hi)); return r; }
__device__ __forceinline__ int crow(int r, int hi) { return (r & 3) + 8 * (r >> 2) + 4 * hi; }
__device__ __forceinline__ bool p2_item(int vcu, int i, int& bh, int& qb) { if (i >= 4) return false; const int s = vcu & 7; bh = vcu >> 3;
    const unsigned w = s == 0 ? 0x0406161bu : s == 1 ? 0x0112131au : s == 2 ? 0x080b0c1du : s == 3 ? 0x0209171fu : s == 4 ? 0x030d111cu : s == 5 ? 0x050f1015u : s == 6 ? 0x00141819u : 0x070a0e1eu;
    qb = (int)((w >> (8 * i)) & 0xffu); return true; }

template <bool YB_GLOBAL>
__device__ __forceinline__ void sgu_item(Frame& F, int b, int h, int qb, LAS unsigned char* stage, const LAS float* Ost, const LAS float* Lst) {
    const bf16 *UG = (const bf16*)(F.ws + WS_UG), *VS = (const bf16*)(F.ws + WS_VS), *GB = (const bf16*)(F.ws + WS_GB), *YB = (const bf16*)((unsigned char*)F.out + 32 * MiB), *Wm = (const bf16*)(F.ws + WS_WM);
    bf16* MG = (bf16*)F.out;
    const float *stats = (const float*)(F.ws + WS_CTL + CT_STATS1), *b_s = F.in[5], *lng = F.in[6], *lnb = F.in[7];
    int tid_ = threadIdx.x; asm volatile("" : "+v"(tid_));
    const int lane = tid_ & 63, r32 = lane & 31, hi = lane >> 5, w = F.wave;
    const size_t row_base = (size_t)b * SEQ + 256 * qb;
    const int cc = w >> 2, tc = w & 3, g = h >> 1;
    v4u wv[4]; float s1[4], s2[4]; unsigned long long stq[4];
#pragma unroll
    for (int i = 0; i < 4; ++i) { const float* sp_ = stats + 2 * (row_base + ((F.tid + 512 * i) >> 3)); asm volatile("global_load_dwordx2 %0, %1, off" : "=v"(stq[i]) : "v"(sp_)); }
#pragma unroll
    for (int i = 0; i < 4; ++i) { const int id = F.tid + 512 * i, srow = id >> 3, pc = id & 7; const size_t row = row_base + srow;
        wv[i] = *(const v4u*)(VS + row * D + 64 * h + 8 * pc); }
    const int pc0 = F.tid & 7;
    const f32x4 g0 = *(const f32x4*)(lng + 64 * h + 8 * pc0), g1 = *(const f32x4*)(lng + 64 * h + 8 * pc0 + 4), c0 = *(const f32x4*)(lnb + 64 * h + 8 * pc0), c1 = *(const f32x4*)(lnb + 64 * h + 8 * pc0 + 4);
    const bf16* wrow = Wm + (size_t)(g * 4 + tc) * 4096 + lane * 8;
    bf16x8 wf[8];
#pragma unroll
    for (int st = 0; st < 8; ++st) wf[st] = *(const bf16x8*)(wrow + 512 * (st < 2 * (tc + 1) ? st : 0));
    const float bs = b_s[g * 128 + 32 * tc + r32];
    asm volatile("s_waitcnt vmcnt(0)" : "+v"(stq[0]), "+v"(stq[1]), "+v"(stq[2]), "+v"(stq[3]) :: "memory");
#pragma unroll
    for (int i = 0; i < 4; ++i) { s1[i] = __uint_as_float((unsigned)stq[i]); s2[i] = __uint_as_float((unsigned)(stq[i] >> 32)); }
#pragma unroll
    for (int i = 0; i < 4; ++i) { const int id = F.tid + 512 * i, srow = id >> 3, pc = id & 7;
        const float mu = s1[i] * (1.0f / 1024.0f), var = fmaxf(s2[i] * (1.0f / 1024.0f) - mu * mu, 0.f), rs = 1.0f / sqrtf(var + EPS);
        v4u o;
        o.x = pk2((bflo(wv[i].x) - mu) * rs * g0.x + c0.x, (bfhi(wv[i].x) - mu) * rs * g0.y + c0.y); o.y = pk2((bflo(wv[i].y) - mu) * rs * g0.z + c0.z, (bfhi(wv[i].y) - mu) * rs * g0.w + c0.w);
        o.z = pk2((bflo(wv[i].z) - mu) * rs * g1.x + c1.x, (bfhi(wv[i].z) - mu) * rs * g1.y + c1.y); o.w = pk2((bflo(wv[i].w) - mu) * rs * g1.z + c1.z, (bfhi(wv[i].w) - mu) * rs * g1.w + c1.w);
        *(LAS v4u*)(stage + srow * 128 + pc * 16) = o; }
    v4u ugv[4], gbv[4];
#pragma unroll
    for (int i = 0; i < 4; ++i) { const int id = F.tid + 512 * i; const size_t off = (row_base + (id >> 3)) * D + 64 * h + 8 * (id & 7); ugv[i] = *(const v4u*)(UG + off); gbv[i] = *(const v4u*)(GB + off); }
    __syncthreads();
    f32x16 acc[2];
#pragma unroll
    for (int r = 0; r < 16; ++r) { acc[0][r] = 0.f; acc[1][r] = 0.f; }
    const lds_cptr abase = (lds_cptr)stage + cc * 16384 + (8 * hi + ((lane & 15) >> 2)) * 128 + (16 * ((lane >> 4) & 1) + 4 * (lane & 3)) * 2;
#pragma unroll
    for (int st = 0; st < 8; ++st) if (st < 2 * (tc + 1)) {
#pragma unroll
        for (int ct = 0; ct < 2; ++ct) { const lds_cptr ap = abase + st * 2048 + ct * 64;
            const bf16x8 af = cat8(vtr(ap), vtr(ap + 512));
            acc[ct] = __builtin_amdgcn_mfma_f32_32x32x16_bf16(af, wf[st], acc[ct], 0, 0, 0); }
    }
    __syncthreads();
    {   LAS unsigned char* mrow = stage + (32 * w + r32) * 144 + 8 * hi;
#pragma unroll
        for (int ct = 0; ct < 2; ++ct)
#pragma unroll
            for (int rg = 0; rg < 4; ++rg)
                *(LAS unsigned long long*)(mrow + (32 * ct + 8 * rg) * 2) = (unsigned long long)cvtpk(acc[ct][4 * rg] + bs, acc[ct][4 * rg + 1] + bs) | ((unsigned long long)cvtpk(acc[ct][4 * rg + 2] + bs, acc[ct][4 * rg + 3] + bs) << 32); }
    __syncthreads();
#pragma unroll
    for (int i = 0; i < 4; ++i) { const int id = F.tid + 512 * i, trow = id >> 3, pc = id & 7; const size_t off = (row_base + trow) * D + 64 * h + 8 * pc;
        const v4u mw = *(const LAS v4u*)(stage + trow * 144 + pc * 16);
        float yb[8];
        if (YB_GLOBAL) { const v4u yw = *(const v4u*)(YB + off); yb[0] = bflo(yw.x); yb[1] = bfhi(yw.x); yb[2] = bflo(yw.y); yb[3] = bfhi(yw.y); yb[4] = bflo(yw.z); yb[5] = bfhi(yw.z); yb[6] = bflo(yw.w); yb[7] = bfhi(yw.w); }
        else { const float rl = 1.0f / Lst[trow]; const f32x4 o0 = *(const LAS f32x4*)(Ost + trow * 68 + 8 * pc), o1 = *(const LAS f32x4*)(Ost + trow * 68 + 8 * pc + 4);
            yb[0] = o0.x * rl; yb[1] = o0.y * rl; yb[2] = o0.z * rl; yb[3] = o0.w * rl; yb[4] = o1.x * rl; yb[5] = o1.y * rl; yb[6] = o1.z * rl; yb[7] = o1.w * rl; }
        const float mx[8] = {bflo(mw.x), bfhi(mw.x), bflo(mw.y), bfhi(mw.y), bflo(mw.z), bfhi(mw.z), bflo(mw.w), bfhi(mw.w)};
        const float ug[8] = {bflo(ugv[i].x), bfhi(ugv[i].x), bflo(ugv[i].y), bfhi(ugv[i].y), bflo(ugv[i].z), bfhi(ugv[i].z), bflo(ugv[i].w), bfhi(ugv[i].w)};
        const float gb[8] = {bflo(gbv[i].x), bfhi(gbv[i].x), bflo(gbv[i].y), bfhi(gbv[i].y), bflo(gbv[i].z), bfhi(gbv[i].z), bflo(gbv[i].w), bfhi(gbv[i].w)};
        v4u o;
        o.x = cvtpk(ug[0] * mx[0] + gb[0] * yb[0], ug[1] * mx[1] + gb[1] * yb[1]); o.y = cvtpk(ug[2] * mx[2] + gb[2] * yb[2], ug[3] * mx[3] + gb[3] * yb[3]);
        o.z = cvtpk(ug[4] * mx[4] + gb[4] * yb[4], ug[5] * mx[5] + gb[5] * yb[5]); o.w = cvtpk(ug[6] * mx[6] + gb[6] * yb[6], ug[7] * mx[7] + gb[7] * yb[7]);
        *(v4u*)(MG + off) = o; }
    __syncthreads();
}
__device__ __forceinline__ void sgu_fast(Frame& F) {
    int bh, qb;
    for (int i = 0; p2_item(F.vcu, i, bh, qb); ++i) sgu_item<true>(F, bh >> 4, bh & 15, qb, F.lds + RING_OFF, nullptr, nullptr);
}

#define LBAR() asm volatile("s_waitcnt lgkmcnt(0)\n\ts_barrier" ::: "memory")
#define PBAR() asm volatile("s_barrier" ::: "memory")
constexpr int OP = 68;
constexpr int QP = 144;
constexpr int TB = 1280, TN = 1537;
constexpr int A_OST = 0, A_LST = 69632, A_MQ = 70656, A_CNT = 71680, A_LIST = 71808, A_LUT = 80000, A_Q = 86160, A_P = 123024, A_END = 156816;
constexpr int PB = 528, PBUF = 32 * PB;
static_assert(A_Q % 16 == 0 && A_P % 16 == 0 && A_LUT + TN * 4 <= A_Q && A_Q + 256 * QP == A_P && A_P + 2 * PBUF == A_END && A_END <= LDSCTL_OFF, "P2 LDS map");
__device__ __forceinline__ void attn_item(Frame& F, int b, int h, int own, int probe = 0) {
    LAS unsigned char* L = F.lds;
    LAS float* Ost = (LAS float*)(L + A_OST); LAS float* Lst = (LAS float*)(L + A_LST); LAS float* MQ = (LAS float*)(L + A_MQ); LAS int* cnt = (LAS int*)(L + A_CNT);
    LAS unsigned char* list = L + A_LIST; LAS float* km = (LAS float*)(L + A_P); LAS float* lut = (LAS float*)(L + A_LUT);
    const bf16 *Qb = (const bf16*)(F.ws + WS_Q) + ((size_t)b * SEQ + 256 * own) * D + 64 * h, *Kb = (const bf16*)(F.ws + WS_K) + (size_t)b * SEQ * D + 64 * h;
    const float *kmean = (const float*)(F.ws + WS_CTL + CT_KMEAN), *glut = (const float*)(F.ws + WS_LUT) + h * 1024, *rel = F.in[8];
    const unsigned* khmax = (const unsigned*)(F.ws + WS_CTL + CT_KHMAX);
    int tid_ = threadIdx.x; asm volatile("" : "+v"(tid_));
    const int tid = tid_, lane = tid & 63, r32 = lane & 31, hi = lane >> 5, w = F.wave, l15 = lane & 15, kg = lane >> 4, ds = w & 3;
    const bf16 *Kf = (const bf16*)(F.ws + WS_K) + (size_t)(b * 16 + h) * (32 * 16384), *Vf = (const bf16*)(F.ws + WS_VA) + (size_t)(b * 16 + h) * (32 * 16384);
    u32x4_t f0[8];
    if (w < 4) { const bf16* kp_ = Kf + w * 4096 + lane * 8;
#pragma unroll
        for (int t = 0; t < 2; ++t)
#pragma unroll
            for (int ks = 0; ks < 4; ++ks) f0[4 * t + ks] = *(const u32x4_t*)(kp_ + t * 2048 + ks * 512); }
    else { const bf16* vp_ = Vf + ds * 4096 + lane * 8;
#pragma unroll
        for (int st = 0; st < 8; ++st) f0[st] = *(const u32x4_t*)(vp_ + st * 512); }
    float kmv[4], tbv[4]; v4u qv[4];
#pragma unroll
    for (int j = 0; j < 4; ++j) { const int i = tid + 512 * j; kmv[j] = i < own * 64 ? kmean[(size_t)(b * 32 + (i >> 6)) * D + 64 * h + (i & 63)] : 0.f; }
#pragma unroll
    for (int j = 0; j < 4; ++j) { const int i = tid + 512 * j; const int dist = TB - i; tbv[j] = (i < TN && dist >= 0) ? glut[dist < 1023 ? dist : 1023] : -INFINITY; }
#pragma unroll
    for (int i = 0; i < 4; ++i) { const int id = tid + 512 * i; qv[i] = *(const v4u*)(Qb + (size_t)(id >> 3) * D + 8 * (id & 7)); }
    const float maxbl = ((const float*)(F.ws + WS_LUT))[16 * 1024 + h], khm0 = __uint_as_float(khmax[b * 32 + 2 * h]), khm1 = __uint_as_float(khmax[b * 32 + 2 * h + 1]);
    for (int i = tid; i < 256 * OP; i += 512) Ost[i] = 0.f;
    if (tid < 256) Lst[tid] = 0.f;
    if (tid < 32) cnt[tid] = 0;
#pragma unroll
    for (int j = 0; j < 4; ++j) { const int i = tid + 512 * j; if (i < own * 64) km[i] = kmv[j]; }
#pragma unroll
    for (int j = 0; j < 4; ++j) { const int i = tid + 512 * j; if (i < TN) lut[i] = tbv[j]; }
#pragma unroll
    for (int i = 0; i < 4; ++i) { const int id = tid + 512 * i; *(LAS v4u*)(L + A_Q + (id >> 3) * QP + (id & 7) * 16) = qv[i]; }
    __syncthreads();
    {
        const LAS unsigned char* qp = L + A_Q + (32 * w + r32) * QP + 16 * hi;
        bf16x8 qf[4];
#pragma unroll
        for (int ks = 0; ks < 4; ++ks) qf[ks] = *(const LAS bf16x8*)(qp + 32 * ks);
        f32x16 G;
#pragma unroll
        for (int r = 0; r < 16; ++r) G[r] = 0.f;
        const LAS float* kr = km + r32 * 64 + 8 * hi;
#pragma unroll
        for (int ks = 0; ks < 4; ++ks) { const f32x4 a = *(const LAS f32x4*)(kr + 16 * ks), c = *(const LAS f32x4*)(kr + 16 * ks + 4);
            const float x[8] = {a.x, a.y, a.z, a.w, c.x, c.y, c.z, c.w}; unsigned hb[8], lb[8];
#pragma unroll
            for (int j = 0; j < 8; ++j) { hb[j] = f2bf(x[j]); lb[j] = f2bf(x[j] - __uint_as_float(hb[j] << 16)); }
            u32x4_t hw, lw; hw.x = hb[0] | (hb[1] << 16); hw.y = hb[2] | (hb[3] << 16); hw.z = hb[4] | (hb[5] << 16); hw.w = hb[6] | (hb[7] << 16);
            lw.x = lb[0] | (lb[1] << 16); lw.y = lb[2] | (lb[3] << 16); lw.z = lb[4] | (lb[5] << 16); lw.w = lb[6] | (lb[7] << 16);
            G = __builtin_amdgcn_mfma_f32_32x32x16_bf16(__builtin_bit_cast(bf16x8, hw), qf[ks], G, 0, 0, 0);
            G = __builtin_amdgcn_mfma_f32_32x32x16_bf16(__builtin_bit_cast(bf16x8, lw), qf[ks], G, 0, 0, 0); }
        float nlo = 0.f, nhi = 0.f;
#pragma unroll
        for (int ks = 0; ks < 4; ++ks) { const u32x4_t qw = __builtin_bit_cast(u32x4_t, qf[ks]);
            const float e[8] = {bflo(qw.x), bfhi(qw.x), bflo(qw.y), bfhi(qw.y), bflo(qw.z), bfhi(qw.z), bflo(qw.w), bfhi(qw.w)}; float t = 0.f;
#pragma unroll
            for (int j = 0; j < 8; ++j) t += e[j] * e[j];
            if (ks < 2) nlo += t; else nhi += t; }
        nlo += __shfl_xor(nlo, 32); nhi += __shfl_xor(nhi, 32);
        if (hi == 0) MQ[32 * w + r32] = sqrtf(nlo) * khm0 + sqrtf(nhi) * khm1 + maxbl + 0.01f;
        float v0 = -INFINITY, v1 = -INFINITY, v2 = -INFINITY; int i0 = 64, i1 = 64, i2 = 64;
#pragma unroll
        for (int r = 0; r < 16; ++r) { const int n = (r & 3) + 8 * (r >> 2) + 4 * hi; const float g = n < own ? G[r] : -INFINITY;
            if (g > v0) { v2 = v1; i2 = i1; v1 = v0; i1 = i0; v0 = g; i0 = n; } else if (g > v1) { v2 = v1; i2 = i1; v1 = g; i1 = n; } else if (g > v2) { v2 = g; i2 = n; } }
        const float pv[3] = {__shfl_xor(v0, 32), __shfl_xor(v1, 32), __shfl_xor(v2, 32)}; const int pi[3] = {__shfl_xor(i0, 32), __shfl_xor(i1, 32), __shfl_xor(i2, 32)};
#pragma unroll
        for (int k = 0; k < 3; ++k) { const float g = pv[k]; const int n = pi[k];
            if (g > v0 || (g == v0 && n < i0)) { v2 = v1; i2 = i1; v1 = v0; i1 = i0; v0 = g; i0 = n; }
            else if (g > v1 || (g == v1 && n < i1)) { v2 = v1; i2 = i1; v1 = g; i1 = n; }
            else if (g > v2 || (g == v2 && n < i2)) { v2 = g; i2 = n; } }
        if (hi == 0) { const int qid = 32 * w + r32;
            if (v0 > -INFINITY) { const int pos = __hip_atomic_fetch_add(cnt + i0, 1, __ATOMIC_RELAXED, __HIP_MEMORY_SCOPE_WORKGROUP); list[i0 * 256 + pos] = (unsigned char)qid; }
            if (v1 > -INFINITY) { const int pos = __hip_atomic_fetch_add(cnt + i1, 1, __ATOMIC_RELAXED, __HIP_MEMORY_SCOPE_WORKGROUP); list[i1 * 256 + pos] = (unsigned char)qid; }
            if (v2 > -INFINITY) { const int pos = __hip_atomic_fetch_add(cnt + i2, 1, __ATOMIC_RELAXED, __HIP_MEMORY_SCOPE_WORKGROUP); list[i2 * 256 + pos] = (unsigned char)qid; } }
    }
    __syncthreads();
    const float bias31 = lut[TB - 1023];
#define NCHUNKS(n_) ((n_) == own ? 8 : max(1, (cnt[(n_)] + 31) >> 5))
    if (!(probe & 1)) {
    if (w < 4) {
        float mitem = fmaxf(fmaxf(MQ[lane], MQ[lane + 64]), fmaxf(MQ[lane + 128], MQ[lane + 192])); mitem = wave_max(mitem);
        const bool useshift = mitem > 96.0f;
        const float shift = useshift ? mitem - 64.0f : 0.f;
        const f32x16 zero16 = {0.f, 0.f, 0.f, 0.f, 0.f, 0.f, 0.f, 0.f, 0.f, 0.f, 0.f, 0.f, 0.f, 0.f, 0.f, 0.f};
        const LAS unsigned char* qrd = L + A_Q + 16 * hi;
        LAS unsigned char* pwr_base = L + A_P + r32 * PB + 128 * w + 8 * hi;
        const bf16* Kw = Kf + w * 4096 + lane * 8;
        u32x4_t kA[2][4], kB[2][4];
        int buf = 0;
#define LOAD_K(dst, n_) do { const int nn_ = (probe & 4) ? 0 : ((n_) < own ? (n_) : own); const bf16* kp0_ = Kw + (size_t)nn_ * 16384; const bf16* kp1_ = kp0_ + 2048; \
        asm volatile("global_load_dwordx4 %0, %1, off" : "=v"(dst[0][0]) : "v"(kp0_)); asm volatile("global_load_dwordx4 %0, %1, off offset:1024" : "=v"(dst[0][1]) : "v"(kp0_)); \
        asm volatile("global_load_dwordx4 %0, %1, off offset:2048" : "=v"(dst[0][2]) : "v"(kp0_)); asm volatile("global_load_dwordx4 %0, %1, off offset:3072" : "=v"(dst[0][3]) : "v"(kp0_)); \
        asm volatile("global_load_dwordx4 %0, %1, off" : "=v"(dst[1][0]) : "v"(kp1_)); asm volatile("global_load_dwordx4 %0, %1, off offset:1024" : "=v"(dst[1][1]) : "v"(kp1_)); \
        asm volatile("global_load_dwordx4 %0, %1, off offset:2048" : "=v"(dst[1][2]) : "v"(kp1_)); asm volatile("global_load_dwordx4 %0, %1, off offset:3072" : "=v"(dst[1][3]) : "v"(kp1_)); } while (0)
#define WAIT_K(x) asm volatile("s_waitcnt vmcnt(8)" : "+v"(x[0][0]), "+v"(x[0][1]), "+v"(x[0][2]), "+v"(x[0][3]), "+v"(x[1][0]), "+v"(x[1][1]), "+v"(x[1][2]), "+v"(x[1][3]) :: "memory")
#define QK_BLOCK(n_, kf) do { const int nq = (n_); const bool isown = nq == own; const int count = isown ? 256 : qcnt; \
        const int ncq = __builtin_amdgcn_readfirstlane(isown ? 8 : max(1, (qcnt + 31) >> 5)); const bool near = (own - nq) <= 4; \
        const int ncnt_ = cnt[nq < 31 ? nq + 1 : 31];                     \
        for (int cq = 0; cq < ncq; ++cq) { \
            LAS unsigned char* pw = pwr_base + buf * PBUF; \
            const int li = 32 * cq + r32; \
            const int qi = isown ? li : (li < count ? qe : 0); \
            const int ne_ = (cq + 1 < ncq) ? (int)list[nq * 256 + li + 32] : (int)list[(nq + 1) * 256 + r32];     \
            if (probe & 8) { } else if (isown && 64 * w > 32 * cq + 31) {                         \
                _Pragma("unroll") for (int g = 0; g < 4; ++g) { *(LAS unsigned long long*)(pw + g * 16) = 0ull; *(LAS unsigned long long*)(pw + 64 + g * 16) = 0ull; } \
            } else { \
            const LAS unsigned char* qp = qrd + qi * QP; bf16x8 qf[4]; \
            _Pragma("unroll") for (int ks = 0; ks < 4; ++ks) qf[ks] = *(const LAS bf16x8*)(qp + 32 * ks); \
            const LAS float* tb = lut + (TB - (256 * (own - nq) + qi - 64 * w - 4 * hi)); \
            f32x16 S0 = __builtin_amdgcn_mfma_f32_32x32x16_bf16(__builtin_bit_cast(bf16x8, kf[0][0]), qf[0], zero16, 0, 0, 0); \
            f32x16 S1 = __builtin_amdgcn_mfma_f32_32x32x16_bf16(__builtin_bit_cast(bf16x8, kf[1][0]), qf[0], zero16, 0, 0, 0); \
            _Pragma("unroll") for (int ks = 1; ks < 4; ++ks) { S0 = __builtin_amdgcn_mfma_f32_32x32x16_bf16(__builtin_bit_cast(bf16x8, kf[0][ks]), qf[ks], S0, 0, 0, 0); S1 = __builtin_amdgcn_mfma_f32_32x32x16_bf16(__builtin_bit_cast(bf16x8, kf[1][ks]), qf[ks], S1, 0, 0, 0); } \
            if (useshift) { _Pragma("unroll") for (int r = 0; r < 16; ++r) { S0[r] -= shift; S1[r] -= shift; } } \
            if (near) { _Pragma("unroll") for (int r = 0; r < 16; ++r) S0[r] += tb[(r & 3) + 8 * (r >> 2)]; } \
            _Pragma("unroll") for (int r = 0; r < 16; ++r) S0[r] = __builtin_amdgcn_exp2f(S0[r]); \
            _Pragma("unroll") for (int g = 0; g < 4; ++g) \
                *(LAS unsigned long long*)(pw + g * 16) = (unsigned long long)cvtpk(S0[4 * g], S0[4 * g + 1]) | ((unsigned long long)cvtpk(S0[4 * g + 2], S0[4 * g + 3]) << 32); \
            asm volatile("" ::: "memory");                                 \
            if (near) { _Pragma("unroll") for (int r = 0; r < 16; ++r) S1[r] += tb[32 + (r & 3) + 8 * (r >> 2)]; } \
            _Pragma("unroll") for (int r = 0; r < 16; ++r) S1[r] = __builtin_amdgcn_exp2f(S1[r]); \
            _Pragma("unroll") for (int g = 0; g < 4; ++g) \
                *(LAS unsigned long long*)(pw + 64 + g * 16) = (unsigned long long)cvtpk(S1[4 * g], S1[4 * g + 1]) | ((unsigned long long)cvtpk(S1[4 * g + 2], S1[4 * g + 3]) << 32); \
            } \
            qe = ne_; \
            LBAR(); \
            buf ^= 1; } \
        qcnt = ncnt_; } while (0)
        int qe = (int)list[r32], qcnt = cnt[0];
#pragma unroll
        for (int t = 0; t < 2; ++t)
#pragma unroll
            for (int ks = 0; ks < 4; ++ks) kA[t][ks] = f0[4 * t + ks];
        for (int n = 0; ; n += 2) {
            LOAD_K(kB, n + 1); WAIT_K(kA); QK_BLOCK(n, kA);
            if (n + 1 > own) break;
            LOAD_K(kA, n + 2); WAIT_K(kB); QK_BLOCK(n + 1, kB);
            if (n + 2 > own) break;
        }
        asm volatile("s_waitcnt vmcnt(0)" ::: "memory");
        LBAR();
#undef WAIT_K
#undef LOAD_K
#undef QK_BLOCK
    } else {
        const LAS unsigned char* prd_base = L + A_P + l15 * PB + kg * 16;
        const bf16* Vw = Vf + ds * 4096 + lane * 8;
        const float sc31 = __builtin_amdgcn_exp2f(bias31);
        const bf16x8 ones = {(short)0x3f80, (short)0x3f80, (short)0x3f80, (short)0x3f80, (short)0x3f80, (short)0x3f80, (short)0x3f80, (short)0x3f80};
        u32x4_t vA[8], vB[8];
        int buf = 0;
#define LOAD_VT(dst, n_) do { const int nn_ = (probe & 4) ? 0 : ((n_) < own ? (n_) : own); const bf16* vp_ = Vw + (size_t)nn_ * 16384; const bf16* vq_ = vp_ + 2048; \
        asm volatile("global_load_dwordx4 %0, %1, off" : "=v"(dst[0]) : "v"(vp_)); asm volatile("global_load_dwordx4 %0, %1, off offset:1024" : "=v"(dst[1]) : "v"(vp_)); \
        asm volatile("global_load_dwordx4 %0, %1, off offset:2048" : "=v"(dst[2]) : "v"(vp_)); asm volatile("global_load_dwordx4 %0, %1, off offset:3072" : "=v"(dst[3]) : "v"(vp_)); \
        asm volatile("global_load_dwordx4 %0, %1, off" : "=v"(dst[4]) : "v"(vq_)); asm volatile("global_load_dwordx4 %0, %1, off offset:1024" : "=v"(dst[5]) : "v"(vq_)); \
        asm volatile("global_load_dwordx4 %0, %1, off offset:2048" : "=v"(dst[6]) : "v"(vq_)); asm volatile("global_load_dwordx4 %0, %1, off offset:3072" : "=v"(dst[7]) : "v"(vq_)); } while (0)
#define WAIT_V(x) asm volatile("s_waitcnt vmcnt(8)" : "+v"(x[0]), "+v"(x[1]), "+v"(x[2]), "+v"(x[3]), "+v"(x[4]), "+v"(x[5]), "+v"(x[6]), "+v"(x[7]) :: "memory")
#define PV_BLOCK(n_, vfr) do { const int np = (n_); const bool isown = np == own; const int count = isown ? 256 : pcnt; \
        const int ncp = __builtin_amdgcn_readfirstlane(isown ? 8 : max(1, (pcnt + 31) >> 5)); const float scf = (own - np) <= 4 ? 1.0f : sc31; \
        const int ncnt_ = cnt[np < 31 ? np + 1 : 31]; \
        for (int cp = 0; cp < ncp; ++cp) { \
            const int li0 = 32 * cp + l15, li1 = li0 + 16; const bool valid0 = li0 < count, valid1 = li1 < count; \
            const int qi0 = isown ? li0 : (valid0 ? pe0 : 0), qi1 = isown ? li1 : (valid1 ? pe1 : 0); \
            const LAS unsigned char* nl_ = (cp + 1 < ncp) ? (list + np * 256 + li0 + 32) : (list + (np + 1) * 256 + l15); \
            const int ne0_ = (int)nl_[0], ne1_ = (int)nl_[16]; \
            if (!(probe & 16)) { \
            const LAS unsigned char* pr = prd_base + buf * PBUF; \
            LAS f32x4* op0 = (LAS f32x4*)(Ost + qi0 * OP + 16 * ds + 4 * kg); LAS f32x4* op1 = (LAS f32x4*)(Ost + qi1 * OP + 16 * ds + 4 * kg); \
            bf16x8 p0[4], p1[4]; \
            _Pragma("unroll") for (int st = 0; st < 4; ++st) { p0[st] = *(const LAS bf16x8*)(pr + st * 64); p1[st] = *(const LAS bf16x8*)(pr + 16 * PB + st * 64); } \
            const f32x4 o0 = *op0, o1 = *op1; \
            f32x4 a0 = {0.f, 0.f, 0.f, 0.f}, a1 = {0.f, 0.f, 0.f, 0.f}, l0 = {0.f, 0.f, 0.f, 0.f}, l1 = {0.f, 0.f, 0.f, 0.f}; \
            _Pragma("unroll") for (int st = 0; st < 4; ++st) { \
                a0 = __builtin_amdgcn_mfma_f32_16x16x32_bf16(__builtin_bit_cast(bf16x8, vfr[st]), p0[st], a0, 0, 0, 0); a1 = __builtin_amdgcn_mfma_f32_16x16x32_bf16(__builtin_bit_cast(bf16x8, vfr[st]), p1[st], a1, 0, 0, 0); \
                if (ds == 0) { l0 = __builtin_amdgcn_mfma_f32_16x16x32_bf16(ones, p0[st], l0, 0, 0, 0); l1 = __builtin_amdgcn_mfma_f32_16x16x32_bf16(ones, p1[st], l1, 0, 0, 0); } } \
            _Pragma("unroll") for (int st = 0; st < 4; ++st) { p0[st] = *(const LAS bf16x8*)(pr + (4 + st) * 64); p1[st] = *(const LAS bf16x8*)(pr + 16 * PB + (4 + st) * 64); } \
            _Pragma("unroll") for (int st = 0; st < 4; ++st) { \
                a0 = __builtin_amdgcn_mfma_f32_16x16x32_bf16(__builtin_bit_cast(bf16x8, vfr[4 + st]), p0[st], a0, 0, 0, 0); a1 = __builtin_amdgcn_mfma_f32_16x16x32_bf16(__builtin_bit_cast(bf16x8, vfr[4 + st]), p1[st], a1, 0, 0, 0); \
                if (ds == 0) { l0 = __builtin_amdgcn_mfma_f32_16x16x32_bf16(ones, p0[st], l0, 0, 0, 0); l1 = __builtin_amdgcn_mfma_f32_16x16x32_bf16(ones, p1[st], l1, 0, 0, 0); } } \
            if (ds == 0 && kg == 0) { if (valid0) Lst[qi0] += l0[0] * scf; if (valid1) Lst[qi1] += l1[0] * scf; } \
            if (valid0) *op0 = o0 + a0 * scf; \
            if (valid1) *op1 = o1 + a1 * scf; \
            } \
            pe0 = ne0_; pe1 = ne1_; \
            PBAR(); \
            buf ^= 1; } \
        pcnt = ncnt_; } while (0)
        int pe0 = (int)list[l15], pe1 = (int)list[16 + l15], pcnt = cnt[0];
#pragma unroll
        for (int st = 0; st < 8; ++st) vA[st] = f0[st];
        LBAR();
        for (int n = 0; ; n += 2) {
            LOAD_VT(vB, n + 1); WAIT_V(vA); PV_BLOCK(n, vA);
            if (n + 1 > own) break;
            LOAD_VT(vA, n + 2); WAIT_V(vB); PV_BLOCK(n + 1, vB);
            if (n + 2 > own) break;
        }
        asm volatile("s_waitcnt vmcnt(0)" ::: "memory");
#undef WAIT_V
#undef LOAD_VT
#undef PV_BLOCK
    }
    }
#undef NCHUNKS
}
__device__ __forceinline__ void p2_fast(Frame& F, int probe = 0) {
    int bh, qb;
    for (int v = F.vcu; v < 256; v += F.G) for (int i = 0; p2_item(v, i, bh, qb); ++i) { attn_item(F, bh >> 4, bh & 15, qb, probe);
        if (!(probe & 2)) sgu_item<false>(F, bh >> 4, bh & 15, qb, F.lds + A_Q, (const LAS float*)(F.lds + A_OST), (const LAS float*)(F.lds + A_LST)); }
}
__device__ __forceinline__ void final_norm(Frame& F) {
    const float *X3 = (const float*)(F.ws + WS_X1), *ss4 = (const float*)(F.ws + WS_CTL + CT_SS4), *gf = F.in[16];
    const int gw = F.vcu * NWAVES + F.wave, NGW = F.G * NWAVES;
    f32x4 gv[4];
#pragma unroll
    for (int j = 0; j < 4; ++j) gv[j] = ((const f32x4*)gf)[F.lane + 64 * j];
    for (int m = gw; m < M; m += NGW) { const float rs = 1.0f / sqrtf(ss4[m] * (1.0f / D) + EPS);
        const f32x4* xr = (const f32x4*)(X3 + (size_t)m * D) + F.lane; f32x4* o = (f32x4*)(F.out + (size_t)m * D) + F.lane;
#pragma unroll
        for (int j = 0; j < 4; ++j) o[64 * j] = xr[64 * j] * rs * gv[j]; }
}

#ifndef MK_N_LAUNCHES
#define MK_N_LAUNCHES 1
#endif
constexpr int N_PHASES = 8;
#ifndef PROBE_P2
#define PROBE_P2 -1
#endif
#ifndef P2FAST
#define P2FAST 1
#endif
struct Args { const float* in[17]; float* out; unsigned char* ws; int ph_lo, ph_hi; };
__global__ void __launch_bounds__(NWAVES * 64, 2) mk_fwd(Args args) {
    extern __shared__ __attribute__((aligned(16))) unsigned char lds[];
    Frame F;
    F.lds = (LAS unsigned char*)lds; F.MISC = (volatile LAS unsigned*)(F.lds + MISC_OFF);
    F.tid = threadIdx.x; F.lane = F.tid & 63; F.wave = __builtin_amdgcn_readfirstlane(F.tid >> 6);
    F.G = gridDim.x; { const int bx = blockIdx.x; F.vcu = (F.G % 8 == 0) ? (bx % 8) * (F.G / 8) + bx / 8 : bx; }
    F.ws = args.ws; F.out = args.out;
#pragma unroll
    for (int i = 0; i < 17; ++i) F.in[i] = args.in[i];
    for (int u = F.tid; u < (LDS_BYTES - LDSCTL_OFF) / 4; u += NWAVES * 64) ((LAS unsigned*)(F.lds + LDSCTL_OFF))[u] = 0u;
    __syncthreads();
    unsigned* barw = (unsigned*)(F.ws + WS_CTL + CT_BAR);
    XcdBarrier bar; bar.bar = barw; bar.x = 0; bar.st = nullptr;
    unsigned boot_ts0 = 0u;
    if (MK_N_LAUNCHES == 1) boot_ts0 = boot_arrive(barw);
    const int lo = args.ph_lo, hi = args.ph_hi;
#define IN(k) (lo <= (k) && (k) < hi)
#define SEAM(k) do { if (IN(k) && IN((k) + 1)) xcd_barrier(bar); } while (0)
#define LSEAM(k) do { if (IN(k) && IN((k) + 1)) { if (grp_ok) quad_barrier(bar, (blockIdx.x & 7u) * 8u + ((blockIdx.x >> 3) & 7u)); else xcd_barrier(bar); } } while (0)
    bool grp_ok = false;
    float* ctl = (float*)(F.ws + WS_CTL);
    bf16* d0 = (bf16*)F.out; bf16* d1 = (bf16*)(F.ws + WS_K);
    if (IN(0)) {
        if (MK_N_LAUNCHES == 1) {
            v4u* cz = (v4u*)(F.ws + WS_CTL); const v4u z4 = {0u, 0u, 0u, 0u};
            for (int i = F.vcu * (NWAVES * 64) + F.tid; i < (int)(CTL_ZERO_BYTES / 16); i += F.G * NWAVES * 64) if (i < (int)(CT_BAR / 16) || i >= (int)((CT_BAR + BARW_TOTAL * 4) / 16)) cz[i] = z4; }
        p0_prologue(F, 0); }
    if (MK_N_LAUNCHES == 1) { boot_wait(boot_ts0); bar = xcd_barrier_post(barw, F.MISC + 8); }
    SEAM(0);
    if (IN(1)) {
        pg8::Gemm g{d0, (const bf16*)(F.ws + WS_WIN), M, NIN, D}; pg8::StaticOrder S; S.init(M, NIN, F.G, (int)blockIdx.x);
        pg8::EpiIn E{(bf16*)(F.ws + WS_UG), (bf16*)(F.ws + WS_VS), (bf16*)(F.ws + WS_Q), (bf16*)(F.ws + WS_K), (bf16*)(F.ws + WS_VA), (bf16*)(F.ws + WS_GB),
                     (float*)(F.ws + WS_CTL + CT_STATS1), (float*)(F.ws + WS_CTL + CT_KMEAN), (unsigned*)(F.ws + WS_CTL + CT_KHMAX), F.lds + RING_BYTES};
        pg8::gemm_phase<pg8::EpiIn, pg8::StaticOrder, true, true>(F.lds + RING_OFF, g, S, E);
    } SEAM(1);
    if (IN(2)) { if (P2FAST) { if (PROBE_P2 >= 0) { int nrep = 2; asm volatile("" : "+s"(nrep)); for (int rep = 0; rep < nrep; ++rep) p2_fast(F, rep + 1 < nrep ? PROBE_P2 : 0); } else p2_fast(F, 0); p0_prologue(F, 1); } else { attn_simple(F); p0_prologue(F, 1); } } SEAM(2);
    if (IN(3)) { if (!P2FAST) sgu_fast(F); } if (!P2FAST || MK_N_LAUNCHES != 1) SEAM(3);
    if (MK_N_LAUNCHES == 1 && IN(4)) grp_ok = grp_local_ok(bar, F.MISC + 10);
    if (IN(4)) {
        pg8::Gemm g{d0, (const bf16*)(F.ws + WS_WOUT), M, D, D}; pg8::StaticOrder S; S.init(M, D, F.G, (int)blockIdx.x);
        pg8::EpiResid<false> E{F.in[0], d1, (float*)(F.ws + WS_CTL + CT_SS2), d1, 1 << 30};
        pg8::gemm_phase<pg8::EpiResid<false>, pg8::StaticOrder, true, true>(F.lds + RING_OFF, g, S, E);
    } LSEAM(4);
    if (MK_N_LAUNCHES == 1 && IN(4) && F.tid == 0) __hip_atomic_fetch_add((unsigned*)(F.ws + WS_CTL + CT_DONE3), 1u, __ATOMIC_RELAXED, __HIP_MEMORY_SCOPE_AGENT);
    if (IN(5)) {
        pg8::Gemm g{d1, (const bf16*)(F.ws + WS_W1), M, FF, D}; pg8::StaticOrder S; S.init(M, FF, F.G, (int)blockIdx.x);
        pg8::EpiFF1 E{(bf16*)(F.ws + WS_A), (const float*)(F.ws + WS_CTL + CT_SS2), EPS};
        pg8::gemm_phase<pg8::EpiFF1, pg8::StaticOrder, true, true>(F.lds + RING_OFF, g, S, E);
    } LSEAM(5);
    if (IN(6)) {
        pg8::Gemm g{(const bf16*)(F.ws + WS_A), (const bf16*)(F.ws + WS_W2), M, D, FF}; pg8::StaticOrder S; S.init(M, D, F.G, (int)blockIdx.x);
        pg8::EpiResid<true> E{d1, (bf16*)(F.ws + WS_X2B_LO), (float*)(F.ws + WS_CTL + CT_SS3), (bf16*)(F.ws + WS_X2B_HI), 8192};
        pg8::gemm_phase<pg8::EpiResid<true>, pg8::StaticOrder, true, true>(F.lds + RING_OFF, g, S, E);
    } LSEAM(6);
    if (MK_N_LAUNCHES == 1 && IN(7) && grp_ok) {
        if (F.tid == 0) { unsigned* c = (unsigned*)(F.ws + WS_CTL + CT_DONE3); unsigned sp = 0; while (__hip_atomic_load(c, __ATOMIC_RELAXED, __HIP_MEMORY_SCOPE_AGENT) < (unsigned)F.G) { __builtin_amdgcn_s_sleep(1); if (++sp > (1u << 22)) break; } }
        __syncthreads(); }
    if (IN(7)) {
        { int kple = PLE; asm volatile("" : "+s"(kple));
          pg8::Gemm g{(const bf16*)(F.ws + WS_PB), (const bf16*)(F.ws + WS_WP), M, D, kple}; pg8::StaticOrder S; S.init(M, D, F.G, (int)blockIdx.x);
          pg8::EpiStore E{(bf16*)(F.ws + WS_PP_LO), (bf16*)(F.ws + WS_PP_HI), PP_ROW2};
          pg8::gemm_phase<pg8::EpiStore, pg8::StaticOrder, true, true>(F.lds + RING_OFF, g, S, E); }
        asm volatile("s_waitcnt vmcnt(0)" ::: "memory"); __syncthreads();
        { pg8::Gemm g{(const bf16*)(F.ws + WS_X2B_LO), (const bf16*)(F.ws + WS_WG), M, D, D, (const bf16*)(F.ws + WS_X2B_HI), 32}; pg8::StaticOrder S; S.init(M, D, F.G, (int)blockIdx.x);
          pg8::EpiPle E{(const bf16*)(F.ws + WS_X2B_LO), (const bf16*)(F.ws + WS_X2B_HI), 8192, (const bf16*)(F.ws + WS_PP_LO), (const bf16*)(F.ws + WS_PP_HI), PP_ROW2, (const float*)(F.ws + WS_CTL + CT_SS3), (float*)(F.ws + WS_CTL + CT_SS4), EPS, (unsigned*)(F.ws + WS_CTL + CT_PCNT), F.in[16], F.out};
          pg8::gemm_phase<pg8::EpiPle, pg8::StaticOrder, true, true>(F.lds + RING_OFF, g, S, E); }
    }
    (void)ctl;
#undef IN
#undef SEAM
#undef LSEAM
}

extern "C" void kernel_launch(void* const* d_in, const int* in_sizes, int n_in, void* d_out, int out_size, void* d_ws, size_t ws_size, hipStream_t stream) {
    static int grid = 0;
    if (grid == 0) {
        if (n_in != 17 || in_sizes[0] != M * D || out_size != M * D || ws_size < WS_END) { fprintf(stderr, "kernel_launch: unexpected shapes (n_in %d, in0 %d, out %d, ws %zu); nothing launched\n", n_in, n_in > 0 ? in_sizes[0] : -1, out_size, ws_size); grid = -1; return; }
        int dev = 0, cus = 0, per_cu = 0;
        if (hipGetDevice(&dev) != hipSuccess || hipDeviceGetAttribute(&cus, hipDeviceAttributeMultiprocessorCount, dev) != hipSuccess) { grid = -1; return; }
        if (hipFuncSetAttribute((const void*)mk_fwd, hipFuncAttributeMaxDynamicSharedMemorySize, LDS_BYTES) != hipSuccess) { fprintf(stderr, "kernel_launch: hipFuncSetAttribute failed\n"); grid = -1; return; }
        if (hipOccupancyMaxActiveBlocksPerMultiprocessor(&per_cu, (const void*)mk_fwd, NWAVES * 64, LDS_BYTES) != hipSuccess || per_cu < 1) fprintf(stderr, "kernel_launch: note: occupancy query reports %d blocks per CU\n", per_cu);
        (void)hipGetLastError();
        grid = cus > 256 ? 256 : cus;
    }
    if (grid < 0) return;
    if (MK_N_LAUNCHES != 1 && hipMemsetAsync((char*)d_ws + WS_CTL, 0, CTL_ZERO_BYTES, stream) != hipSuccess) { fprintf(stderr, "kernel_launch: memset failed\n"); return; }
    Args a{};
    for (int i = 0; i < 17; ++i) a.in[i] = (const float*)d_in[i];
    a.out = (float*)d_out; a.ws = (unsigned char*)d_ws;
    if (MK_N_LAUNCHES == 1) { a.ph_lo = 0; a.ph_hi = N_PHASES; hipLaunchKernelGGL(mk_fwd, dim3(grid), dim3(NWAVES * 64), LDS_BYTES, stream, a); }
    else for (int ph = 0; ph < N_PHASES; ++ph) { a.ph_lo = ph; a.ph_hi = ph + 1; hipLaunchKernelGGL(mk_fwd, dim3(grid), dim3(NWAVES * 64), LDS_BYTES, stream, a); }
}
```
